# Optimizing an MI355X kernel written in HIP

```python
import math
import jax, jax.numpy as jnp
from jax import lax
import numpy as np

D_MODEL = 2048
BATCH = 4
SEQ = 2048
DEPTH = 1

D_MIX = D_MODEL
ATTN_WIDTH = D_MIX // 2
GMLP_WIDTH = D_MIX - ATTN_WIDTH
ATTN_HEAD_DIM = 128
N_ATTN_HEADS = ATTN_WIDTH // ATTN_HEAD_DIM
DIFF_HALF = ATTN_HEAD_DIM // 2
ROPE_DIM = DIFF_HALF // 4
ROPE_THETA = 500000.0
N_GMLP_HEADS = 8
GMLP_HEAD_DIM = GMLP_WIDTH // N_GMLP_HEADS
CHUNK = 128
Q_BLOCK = 128
QK_WIDTH = N_ATTN_HEADS * 2 * DIFF_HALF
IN_WIDTH = 2 * QK_WIDTH + ATTN_WIDTH + 2 * GMLP_WIDTH
D_FF = 5632
CONV_WIDTH = 3
PLE_DIM = 256
EPS = 1e-6

kernel_name = "hybrid_diffattn_gmlp_convffn_encoder"


def rms_norm(x, g):
    xf = x.astype(jnp.float32)
    y = xf * lax.rsqrt(jnp.mean(xf * xf, axis=-1, keepdims=True) + EPS)
    return (y * g.astype(jnp.float32)).astype(x.dtype)


def layer_norm(x, g, b):
    xf = x.astype(jnp.float32)
    mu = jnp.mean(xf, axis=-1, keepdims=True)
    var = jnp.mean(jnp.square(xf - mu), axis=-1, keepdims=True)
    y = (xf - mu) * lax.rsqrt(var + EPS)
    return (y * g.astype(jnp.float32) + b.astype(jnp.float32)).astype(x.dtype)


def rope_tables(positions, dtype):
    inv_freq = ROPE_THETA ** (-jnp.arange(0, ROPE_DIM, 2, dtype=jnp.float32) / ROPE_DIM)
    ang = positions.astype(jnp.float32)[..., None] * inv_freq
    cos = jnp.cos(ang)[:, :, None, None, :].astype(dtype)
    sin = jnp.sin(ang)[:, :, None, None, :].astype(dtype)
    return cos, sin


def apply_partial_rope(t, cos, sin):
    half = ROPE_DIM // 2
    r1 = t[..., :half]
    r2 = t[..., half:ROPE_DIM]
    rotated = jnp.concatenate([r1 * cos - r2 * sin, r2 * cos + r1 * sin], axis=-1)
    return jnp.concatenate([rotated, t[..., ROPE_DIM:]], axis=-1)


def diff_attention(q, k, v, lam, lambda_init, g_subln):
    B, S = q.shape[0], q.shape[1]
    nb = S // Q_BLOCK
    scale = DIFF_HALF ** -0.5
    qb = q.reshape(B, nb, Q_BLOCK, N_ATTN_HEADS, 2, DIFF_HALF).transpose(1, 0, 2, 3, 4, 5)

    def block(qi):
        s = jnp.einsum('bqhcd,bkhcd->bhcqk', qi, k).astype(jnp.float32) * scale
        pr = jax.nn.softmax(s, axis=-1)
        a = pr[:, :, 0] - lam * pr[:, :, 1]
        return jnp.einsum('bhqk,bkhd->bqhd', a.astype(v.dtype), v)

    o = lax.map(block, qb)
    o = o.transpose(1, 0, 2, 3, 4).reshape(B, S, N_ATTN_HEADS, ATTN_HEAD_DIM)
    o = rms_norm(o, g_subln) * (1.0 - lambda_init)
    return o.reshape(B, S, ATTN_WIDTH)


def spatial_gating(u, v, ln_g, ln_b, w_s, b_s):
    B, S = u.shape[0], u.shape[1]
    u = jax.nn.gelu(u, approximate=False)
    v = layer_norm(jax.nn.gelu(v, approximate=False), ln_g, ln_b)
    vc = v.reshape(B, S // CHUNK, CHUNK, N_GMLP_HEADS, GMLP_HEAD_DIM)
    mixed = jnp.einsum('hpq,bcqhd->bcphd', w_s, vc) + b_s.T[None, None, :, :, None]
    return u * mixed.reshape(B, S, GMLP_WIDTH)


def conv_glu_ffn(x, w_up, conv_w, conv_b, w_down):
    h = x @ w_up
    hp = jnp.pad(h, ((0, 0), (1, 1), (0, 0)))
    h = hp[:, :-2] * conv_w[0] + hp[:, 1:-1] * conv_w[1] + hp[:, 2:] * conv_w[2] + conv_b
    g, u = jnp.split(h, 2, axis=-1)
    return (jax.nn.silu(g) * u) @ w_down


def setup_inputs(seed: int = 0) -> dict:
    key = jax.random.key(seed)
    ks = jax.random.split(key, 24)
    f32 = jnp.float32
    nrm = lambda k, shape, s: jax.random.normal(k, shape, f32) * s
    gain = lambda k, shape: 1.0 + 0.05 * jax.random.normal(k, shape, f32)
    L = DEPTH
    x = jax.random.normal(ks[0], (BATCH, SEQ, D_MODEL), f32)
    p = jax.random.normal(ks[1], (DEPTH, BATCH, SEQ, PLE_DIM), f32)
    positions = jnp.broadcast_to(jnp.arange(SEQ, dtype=jnp.int32), (BATCH, SEQ))
    return {
        "x": x,
        "p": p,
        "positions": positions,
        "g_mix": gain(ks[2], (L, D_MODEL)),
        "w_in": nrm(ks[3], (L, D_MODEL, IN_WIDTH), D_MODEL ** -0.5),
        "lambda_q1": nrm(ks[4], (L, DIFF_HALF), 0.1),
        "lambda_k1": nrm(ks[5], (L, DIFF_HALF), 0.1),
        "lambda_q2": nrm(ks[6], (L, DIFF_HALF), 0.1),
        "lambda_k2": nrm(ks[7], (L, DIFF_HALF), 0.1),
        "g_subln": gain(ks[8], (L, ATTN_HEAD_DIM)),
        "gmlp_ln_g": gain(ks[9], (L, GMLP_WIDTH)),
        "gmlp_ln_b": nrm(ks[10], (L, GMLP_WIDTH), 0.02),
        "w_spatial": nrm(ks[11], (L, N_GMLP_HEADS, CHUNK, CHUNK), CHUNK ** -0.5),
        "b_spatial": gain(ks[12], (L, N_GMLP_HEADS, CHUNK)),
        "w_out": nrm(ks[13], (L, D_MIX, D_MODEL), D_MIX ** -0.5),
        "g_ffn": gain(ks[14], (L, D_MODEL)),
        "w_up": nrm(ks[15], (L, D_MODEL, 2 * D_FF), D_MODEL ** -0.5),
        "conv_w": nrm(ks[16], (L, CONV_WIDTH, 2 * D_FF), CONV_WIDTH ** -0.5),
        "conv_b": nrm(ks[17], (L, 2 * D_FF), 0.02),
        "w_down": nrm(ks[18], (L, D_FF, D_MODEL), D_FF ** -0.5),
        "g_ple": gain(ks[19], (L, D_MODEL)),
        "w_ple_gate": nrm(ks[20], (L, D_MODEL, D_MODEL), D_MODEL ** -0.5),
        "w_ple_up": nrm(ks[21], (L, PLE_DIM, D_MODEL), PLE_DIM ** -0.5),
        "g_final": gain(ks[22], (D_MODEL,)),
    }


def reference(x, p, positions, g_mix, w_in, lambda_q1, lambda_k1, lambda_q2, lambda_k2,
              g_subln, gmlp_ln_g, gmlp_ln_b, w_spatial, b_spatial, w_out, g_ffn,
              w_up, conv_w, conv_b, w_down, g_ple, w_ple_gate, w_ple_up, g_final):
    B, S = x.shape[0], x.shape[1]
    cos, sin = rope_tables(positions, x.dtype)
    h = x
    for i in range(DEPTH):
        a = rms_norm(h, g_mix[i])
        z = a @ w_in[i]
        o0, o1, o2, o3 = QK_WIDTH, 2 * QK_WIDTH, 2 * QK_WIDTH + ATTN_WIDTH, 2 * QK_WIDTH + ATTN_WIDTH + GMLP_WIDTH
        q = z[..., :o0].reshape(B, S, N_ATTN_HEADS, 2, DIFF_HALF)
        k = z[..., o0:o1].reshape(B, S, N_ATTN_HEADS, 2, DIFF_HALF)
        v = z[..., o1:o2].reshape(B, S, N_ATTN_HEADS, ATTN_HEAD_DIM)
        gu = z[..., o2:o3]
        gv = z[..., o3:]
        q = apply_partial_rope(q, cos, sin)
        k = apply_partial_rope(k, cos, sin)
        lambda_init = 0.8 - 0.6 * math.exp(-0.3 * i)
        lam = (jnp.exp(jnp.sum(lambda_q1[i].astype(jnp.float32) * lambda_k1[i].astype(jnp.float32)))
               - jnp.exp(jnp.sum(lambda_q2[i].astype(jnp.float32) * lambda_k2[i].astype(jnp.float32)))
               + lambda_init)
        attn_out = diff_attention(q, k, v, lam, lambda_init, g_subln[i])
        gmlp_out = spatial_gating(gu, gv, gmlp_ln_g[i], gmlp_ln_b[i],
                                  w_spatial[i], b_spatial[i])
        mix = jnp.concatenate([attn_out, gmlp_out], axis=-1)
        h = h + mix @ w_out[i]
        h = h + conv_glu_ffn(rms_norm(h, g_ffn[i]), w_up[i], conv_w[i], conv_b[i], w_down[i])
        gate = jax.nn.sigmoid(rms_norm(h, g_ple[i]) @ w_ple_gate[i])
        h = h + (p[i] @ w_ple_up[i]) * gate
    return rms_norm(h, g_final)
```

```cpp
#include <hip/hip_runtime.h>
#include <cstdio>
#include <cstdint>

#ifndef MK_N_LAUNCHES
#define MK_N_LAUNCHES 1
#endif

#define LAS __attribute__((address_space(3)))
#define GAS __attribute__((address_space(1)))
typedef unsigned short bf16_t;
typedef short bf16x8 __attribute__((ext_vector_type(8)));
typedef short s16x4 __attribute__((ext_vector_type(4)));
typedef float f32x4 __attribute__((ext_vector_type(4)));
typedef float f32x2 __attribute__((ext_vector_type(2)));
typedef float f32x16 __attribute__((ext_vector_type(16)));
typedef unsigned u32x4 __attribute__((ext_vector_type(4)));
typedef unsigned u32x2 __attribute__((ext_vector_type(2)));
typedef __bf16 bf16x2_t __attribute__((ext_vector_type(2)));

constexpr int DM = 2048, NBATCH = 4, SEQ = 2048, MTOK = NBATCH * SEQ;
constexpr int NIN = 5120, PARTW = 1024, DFF = 5632, NUP = 2 * DFF, PLE = 256, NHEAD = 8;
constexpr float EPS = 1e-6f;
constexpr float LOG2E = 1.4426950408889634f;
constexpr float C2 = 0.125f * LOG2E;
constexpr float LAMBDA_INIT = 0.2f;

constexpr size_t MiB = 1u << 20;
constexpr size_t WS_CTL = 0, CTL_ZERO_BYTES = 64 * 1024;
constexpr size_t WS_ROPE = 1 * MiB;
constexpr size_t WS_LNST = 2 * MiB;
constexpr size_t WS_SSQ  = 3 * MiB;
constexpr size_t WS_WPUT = 4 * MiB;
constexpr size_t WS_PB   = 5 * MiB;
constexpr size_t WS_HALO = 9 * MiB;
constexpr size_t WS_WINT = 16 * MiB;
constexpr size_t WS_WOUTT = 36 * MiB;
constexpr size_t WS_WUPT = 44 * MiB;
constexpr size_t WS_WDT  = 88 * MiB;
constexpr size_t WS_WGT  = 110 * MiB;
constexpr size_t WS_A    = 118 * MiB;
constexpr size_t WS_H    = 150 * MiB;
constexpr size_t WS_UPB  = 182 * MiB;
constexpr size_t WS_QKVUG = 214 * MiB;
constexpr size_t PART_ELEMS = (size_t)MTOK * PARTW;
constexpr size_t WS_MIX  = 294 * MiB;
constexpr size_t WS_ACT  = 214 * MiB;
constexpr size_t WS_END  = 326 * MiB;
static_assert(WS_ACT + (size_t)MTOK * DFF * 2 <= WS_END && WS_MIX + (size_t)MTOK * DM * 2 <= WS_END, "ws map");

constexpr int CW_BAR = 1024;
constexpr int CW_PANEL = 8192;
constexpr int CW_QA = 4608, CW_QB = 5120, CW_DONE1 = 192, CW_DONE4 = 256;

constexpr int RING_BYTES = 131072;
constexpr int XLDS_OFF = RING_BYTES;
constexpr int LDS_BYTES = 147456;
constexpr int LDSCTL_OFF = LDS_BYTES - 512;
constexpr int CONV_LDS_PER_WAVE = 64 * 65 * 4;
static_assert(XLDS_OFF + 8192 <= LDSCTL_OFF && 8 * CONV_LDS_PER_WAVE <= LDSCTL_OFF, "lds map");

__device__ __forceinline__ unsigned f2bf(float f) { unsigned u = __builtin_bit_cast(unsigned, f); return (u + 0x7fffu + ((u >> 16) & 1u)) >> 16; }
__device__ __forceinline__ unsigned pk2(float lo, float hi) { f32x2 v = {lo, hi}; bf16x2_t b = __builtin_convertvector(v, bf16x2_t); return __builtin_bit_cast(unsigned, b); }
__device__ __forceinline__ float bf2f(unsigned short b) { return __builtin_bit_cast(float, (unsigned)b << 16); }
__device__ __forceinline__ float wave_sum(float v) {
#pragma unroll
    for (int o = 1; o < 64; o <<= 1) v += __shfl_xor(v, o);
    return v;
}
#define LDS_WAIT() asm volatile("s_waitcnt lgkmcnt(0)" ::: "memory")
#define VM_WAIT() asm volatile("s_waitcnt vmcnt(0)" ::: "memory")

__device__ __forceinline__ int fresh_lane() { int l; asm volatile("v_mbcnt_lo_u32_b32 %0, -1, 0\n\tv_mbcnt_hi_u32_b32 %0, -1, %0" : "=v"(l)); return l; }
namespace pg8 {
constexpr int BM = 256, BK = 64, HALF = 128, HTB = HALF * BK * 2, STAGE_BYTES = 8 * HTB, NXCD = 8, WGM = 8;
__host__ __device__ __forceinline__ int lds_byte(int r, int c) { const int st = (r >> 4) * 2 + (c >> 5), rr = r & 15, cc = c & 31, ob = rr * 64 + cc * 2; return st * 1024 + (ob ^ (((ob >> 9) & 1) << 5)); }
__host__ __device__ __forceinline__ void stage_rc(int b, int& R, int& C) { const int st = b / 1024, sb = b % 1024, swz = sb ^ (((sb >> 9) & 1) << 5); R = (st >> 1) * 16 + swz / 64; C = (st & 1) * 32 + (swz % 64) / 2; }
__host__ __device__ __forceinline__ int perm32(int rho) { const int n = rho >> 4, i = rho & 15; return 8 * (i >> 2) + 4 * n + (i & 3); }

struct Unit { int pm, pn; };
struct Gemm { const bf16_t* A; const bf16_t* Bt; int M, N, K; };

struct StaticOrder {
    int nM, nN, nwg, G, c;
    __host__ __device__ void init(int M, int N, int G_, int c_) { nM = M / BM; nN = N / BM; nwg = nM * nN; G = G_; c = c_; }
    __host__ __device__ bool next(int i, Unit& u) const {
        const long L = (long)i * G + c; if (L >= nwg) return false;
        int wgid = (int)L; { const int q = nwg / NXCD, r = nwg % NXCD, xcd = wgid % NXCD, off = wgid / NXCD; wgid = (xcd < r ? xcd * (q + 1) : r * (q + 1) + (xcd - r) * q) + off; }
        const int nig = WGM * nN, gid = wgid / nig, fm = gid * WGM, gsz = (nM - fm) < WGM ? (nM - fm) : WGM;
        u.pm = fm + ((wgid % nig) % gsz); u.pn = (wgid % nig) / gsz; return true;
    }
    __device__ __forceinline__ void a_ready(const Unit&) const {}
    __device__ __forceinline__ void done(const Unit&) const {}
};

struct SmallOrder {
    int first, stride, count;
    __device__ __forceinline__ bool next(int i, Unit& u) const { if (i >= count) return false; const int v = first + i * stride; u.pm = v >> 3; u.pn = v & 7; return true; }
    __device__ __forceinline__ void a_ready(const Unit&) const {}
    __device__ __forceinline__ void done(const Unit&) const {}
};

__device__ __forceinline__ f32x2 gelu_pk(f32x2 v) {
    const f32x2 av = __builtin_elementwise_abs(v), d = av * 0.2316418882f + 1.0f;
    f32x2 t; t.x = __builtin_amdgcn_rcpf(d.x); t.y = __builtin_amdgcn_rcpf(d.y);
    f32x2 q = t * 0.5307027145f + (-0.7265760135f); q = q * t + 0.7107068705f; q = q * t + (-0.142248368f); q = q * t + 0.127414796f; q = q * t;
    const f32x2 s = (v * v) * (-0.72134752044f);
    f32x2 e; e.x = __builtin_amdgcn_exp2f(s.x); e.y = __builtin_amdgcn_exp2f(s.y);
    const f32x2 m = v * (q * e), r = v - m;
    f32x2 o; o.x = v.x < 0.f ? m.x : r.x; o.y = v.y < 0.f ? m.y : r.y; return o;
}
__device__ __forceinline__ f32x4 gelu4(f32x4 v) { const f32x2 a = gelu_pk((f32x2){v[0], v[1]}), b = gelu_pk((f32x2){v[2], v[3]}); return (f32x4){a.x, a.y, b.x, b.y}; }
__device__ __forceinline__ u32x4 pack8(f32x4 v0, f32x4 v1) { u32x4 w; w.x = pk2(v0[0], v0[1]); w.y = pk2(v0[2], v0[3]); w.z = pk2(v1[0], v1[1]); w.w = pk2(v1[2], v1[3]); return w; }
__device__ __forceinline__ float dot4(f32x4 a) { return (a[0] * a[0] + a[1] * a[1]) + (a[2] * a[2] + a[3] * a[3]); }
__device__ __forceinline__ float sum4(f32x4 a) { return (a[0] + a[1]) + (a[2] + a[3]); }
__device__ __forceinline__ f32x4 shfl_xor4(f32x4 v, int m) { return (f32x4){__shfl_xor(v[0], m), __shfl_xor(v[1], m), __shfl_xor(v[2], m), __shfl_xor(v[3], m)}; }


struct EpiIn {
    static constexpr bool PERM = true, AFTER_DRAIN = false;
    bf16_t* qkvug; const float* rope; float* lnstat;
    __device__ __forceinline__ void operator()(f32x4 (&acc)[2][2][4][2], const Unit& u, int wr, int wc, int fr, int fq) const {
        const int t = u.pn >> 2, colt = (u.pn & 3) * BM;
        bf16_t* base = qkvug + (size_t)t * PART_ELEMS;
        const int row0 = u.pm * BM + wr * 64 + fr, col0 = colt + wc * 32 + 8 * fq;
        if (t <= 1) {
            const float sc = (t == 0) ? C2 : 1.0f;
            const bool rotw = ((wc & 1) == 0);
            const float sgn = (fq == 0) ? -1.0f : 1.0f;
#pragma unroll
            for (int ai = 0; ai < 2; ++ai)
#pragma unroll
                for (int m = 0; m < 4; ++m) {
                    const int row = row0 + ai * HALF + m * 16;
                    f32x4 c0 = {1.f, 1.f, 1.f, 1.f}, c1 = c0, s0 = {0.f, 0.f, 0.f, 0.f}, s1 = s0;
                    if (rotw) { const float* rp = rope + (size_t)row * 16; c0 = *(const f32x4*)(rp); c1 = *(const f32x4*)(rp + 4); s0 = *(const f32x4*)(rp + 8); s1 = *(const f32x4*)(rp + 12); }
#pragma unroll
                    for (int bj = 0; bj < 2; ++bj) {
                        f32x4 v0 = acc[ai][bj][m][0], v1 = acc[ai][bj][m][1];
                        if (rotw) {
                            const f32x4 p0 = shfl_xor4(v0, 16), p1 = shfl_xor4(v1, 16);
                            const f32x4 r0 = v0 * c0 + (p0 * s0) * sgn, r1 = v1 * c1 + (p1 * s1) * sgn;
                            if (fq < 2) { v0 = r0; v1 = r1; }
                        }
                        v0 = v0 * sc; v1 = v1 * sc;
                        *(u32x4*)(base + (size_t)row * PARTW + col0 + bj * HALF) = pack8(v0, v1);
                    }
                }
        } else if (t == 2) {
#pragma unroll
            for (int ai = 0; ai < 2; ++ai)
#pragma unroll
                for (int m = 0; m < 4; ++m) {
                    const int row = row0 + ai * HALF + m * 16;
#pragma unroll
                    for (int bj = 0; bj < 2; ++bj) *(u32x4*)(base + (size_t)row * PARTW + col0 + bj * HALF) = pack8(acc[ai][bj][m][0], acc[ai][bj][m][1]);
                }
        } else {
#pragma unroll
            for (int ai = 0; ai < 2; ++ai)
#pragma unroll
                for (int m = 0; m < 4; ++m) {
                    const int row = row0 + ai * HALF + m * 16;
                    float s = 0.f, q = 0.f;
#pragma unroll
                    for (int bj = 0; bj < 2; ++bj) {
                        const f32x4 v0 = gelu4(acc[ai][bj][m][0]), v1 = gelu4(acc[ai][bj][m][1]);
                        s += sum4(v0) + sum4(v1); q += dot4(v0) + dot4(v1);
                        *(u32x4*)(base + (size_t)row * PARTW + col0 + bj * HALF) = pack8(v0, v1);
                    }
                    if (t == 4) {
                        s += __shfl_xor(s, 16); s += __shfl_xor(s, 32); q += __shfl_xor(q, 16); q += __shfl_xor(q, 32);
                        if (fq == 0) *(f32x2*)(lnstat + ((size_t)row * 16 + (u.pn & 3) * 4 + wc) * 2) = (f32x2){s, q};
                    }
                }
        }
    }
};

struct EpiBf16 {
    static constexpr bool PERM = true, AFTER_DRAIN = false;
    bf16_t* C; int ldc;
    __device__ __forceinline__ void operator()(f32x4 (&acc)[2][2][4][2], const Unit& u, int wr, int wc, int fr, int fq) const {
        const int row0 = u.pm * BM + wr * 64 + fr, col0 = u.pn * BM + wc * 32 + 8 * fq;
#pragma unroll
        for (int ai = 0; ai < 2; ++ai)
#pragma unroll
            for (int m = 0; m < 4; ++m) { bf16_t* rowp = C + (size_t)(row0 + ai * HALF + m * 16) * ldc + col0;
#pragma unroll
                for (int bj = 0; bj < 2; ++bj) *(u32x4*)(rowp + bj * HALF) = pack8(acc[ai][bj][m][0], acc[ai][bj][m][1]); }
    }
};
struct EpiF32 {
    static constexpr bool PERM = true, AFTER_DRAIN = false;
    float* C; int ldc;
    __device__ __forceinline__ void operator()(f32x4 (&acc)[2][2][4][2], const Unit& u, int wr, int wc, int fr, int fq) const {
        const int row0 = u.pm * BM + wr * 64 + fr, col0 = u.pn * BM + wc * 32 + 8 * fq;
#pragma unroll
        for (int ai = 0; ai < 2; ++ai)
#pragma unroll
            for (int m = 0; m < 4; ++m) { float* rowp = C + (size_t)(row0 + ai * HALF + m * 16) * ldc + col0;
#pragma unroll
                for (int bj = 0; bj < 2; ++bj) { *(f32x4*)(rowp + bj * HALF) = acc[ai][bj][m][0]; *(f32x4*)(rowp + bj * HALF + 4) = acc[ai][bj][m][1]; } }
    }
};

__device__ __forceinline__ void unpack8(u32x4 w, f32x4& a, f32x4& b) {
    a = (f32x4){__builtin_bit_cast(float, w.x << 16), __builtin_bit_cast(float, w.x & 0xffff0000u), __builtin_bit_cast(float, w.y << 16), __builtin_bit_cast(float, w.y & 0xffff0000u)};
    b = (f32x4){__builtin_bit_cast(float, w.z << 16), __builtin_bit_cast(float, w.z & 0xffff0000u), __builtin_bit_cast(float, w.w << 16), __builtin_bit_cast(float, w.w & 0xffff0000u)};
}
template <int MODE>
struct EpiResid {
    static constexpr bool PERM = true, AFTER_DRAIN = false;
    const void* base; bf16_t* out; float* ssq; const float* sd0; const float* gmix;
    __device__ __forceinline__ void operator()(f32x4 (&acc)[2][2][4][2], const Unit& u, int wr, int wc, int fr, int fq) const {
        const int row0 = u.pm * BM + wr * 64 + fr, col0 = u.pn * BM + wc * 32 + 8 * fq;
        f32x4 gi[2][2];
        if (MODE == 2) {
#pragma unroll
            for (int bj = 0; bj < 2; ++bj)
#pragma unroll
                for (int n = 0; n < 2; ++n) { const f32x4 gq = *(const f32x4*)(gmix + col0 + bj * HALF + 4 * n);
#pragma unroll
                    for (int j = 0; j < 4; ++j) gi[bj][n][j] = (gq[j] != 0.f) ? __builtin_amdgcn_rcpf(gq[j]) : 0.f; }
        }
#pragma unroll
        for (int ai = 0; ai < 2; ++ai)
#pragma unroll
            for (int m = 0; m < 4; ++m) {
                const int row = row0 + ai * HALF + m * 16; float ss = 0.f;
                float sd = 1.f; if (MODE == 2) sd = sd0[row];
#pragma unroll
                for (int bj = 0; bj < 2; ++bj) {
                    const size_t off = (size_t)row * DM + col0 + bj * HALF;
                    f32x4 b0, b1;
                    if (MODE == 0) { b0 = *(const f32x4*)((const float*)base + off); b1 = *(const f32x4*)((const float*)base + off + 4); }
                    else { unpack8(*(const u32x4*)((const bf16_t*)base + off), b0, b1); if (MODE == 2) { b0 = b0 * sd * gi[bj][0]; b1 = b1 * sd * gi[bj][1]; } }
                    const f32x4 h0 = b0 + acc[ai][bj][m][0], h1 = b1 + acc[ai][bj][m][1];
                    ss += dot4(h0) + dot4(h1);
                    *(u32x4*)(out + off) = pack8(h0, h1);
                }
                ss += __shfl_xor(ss, 16); ss += __shfl_xor(ss, 32);
                if (fq == 0) unsafeAtomicAdd(ssq + row, ss);
            }
    }
};

template <bool FUSED>
struct EpiPle {
    static constexpr bool PERM = true, AFTER_DRAIN = false;
    const bf16_t* h; const bf16_t* upb; float* out; const float* ssq_in; float* ssq; unsigned* cnt; const float* gfin;
    __device__ __forceinline__ void operator()(f32x4 (&acc)[2][2][4][2], const Unit& u, int wr, int wc, int fr, int fq) const {
        const int row0 = u.pm * BM + wr * 64 + fr, col0 = u.pn * BM + wc * 32 + 8 * fq;
#pragma unroll
        for (int ai = 0; ai < 2; ++ai)
#pragma unroll
            for (int m = 0; m < 4; ++m) {
                const int row = row0 + ai * HALF + m * 16; float ss = 0.f;
                const float rs = __builtin_amdgcn_rsqf(ssq_in[row] * (1.0f / DM) + EPS) * (-LOG2E);
#pragma unroll
                for (int bj = 0; bj < 2; ++bj) {
                    const size_t off = (size_t)row * DM + col0 + bj * HALF;
                    f32x4 hb[2], ub[2]; unpack8(*(const u32x4*)(h + off), hb[0], hb[1]); unpack8(*(const u32x4*)(upb + off), ub[0], ub[1]);
#pragma unroll
                    for (int n = 0; n < 2; ++n) {
                        const f32x4 z = acc[ai][bj][m][n] * rs;
                        f32x4 gt;
#pragma unroll
                        for (int j = 0; j < 4; ++j) gt[j] = __builtin_amdgcn_rcpf(1.0f + __builtin_amdgcn_exp2f(z[j]));
                        const f32x4 h3 = hb[n] + ub[n] * gt;
                        if (FUSED) acc[ai][bj][m][n] = h3; else *(f32x4*)(out + off + 4 * n) = h3;
                        ss += dot4(h3);
                    }
                }
                ss += __shfl_xor(ss, 16); ss += __shfl_xor(ss, 32);
                if (fq == 0) unsafeAtomicAdd(ssq + row, ss);
                asm volatile("" ::: "memory");
            }
        if (FUSED) {
            asm volatile("s_waitcnt vmcnt(0)" ::: "memory");
            unsigned* pc = cnt + 64 * u.pm;
            if ((threadIdx.x & 63) == 0) (void)__hip_atomic_fetch_add(pc, 1u, __ATOMIC_RELAXED, __HIP_MEMORY_SCOPE_AGENT);
            { unsigned sp = 0;
              while ((unsigned)__builtin_amdgcn_readfirstlane((int)__hip_atomic_load(pc, __ATOMIC_RELAXED, __HIP_MEMORY_SCOPE_AGENT)) < 64u) { __builtin_amdgcn_s_sleep(2); if (++sp > (1u << 20)) break; } }
            f32x4 gf[2][2];
#pragma unroll
            for (int bj = 0; bj < 2; ++bj)
#pragma unroll
                for (int n = 0; n < 2; ++n) gf[bj][n] = *(const f32x4*)(gfin + col0 + bj * HALF + 4 * n);
#pragma unroll
            for (int ai = 0; ai < 2; ++ai)
#pragma unroll
                for (int m = 0; m < 4; ++m) {
                    const int row = row0 + ai * HALF + m * 16;
                    float tot = 0.f; if (fq == 0) tot = unsafeAtomicAdd(ssq + row, 0.0f);
                    tot = __shfl(tot, fr);
                    const float rn = __builtin_amdgcn_rsqf(tot * (1.0f / DM) + EPS);
#pragma unroll
                    for (int bj = 0; bj < 2; ++bj)
#pragma unroll
                        for (int n = 0; n < 2; ++n) *(f32x4*)(out + (size_t)row * DM + col0 + bj * HALF + 4 * n) = acc[ai][bj][m][n] * rn * gf[bj][n];
                }
        }
    }
};

__device__ __forceinline__ float dpp_ror1(float v) { float r; asm volatile("s_nop 1\n\tv_mov_b32_dpp %0, %1 row_ror:1 row_mask:0xf bank_mask:0xf" : "=v"(r) : "v"(v)); return r; }
__device__ __forceinline__ float dpp_rol1(float v) { float r; asm volatile("s_nop 1\n\tv_mov_b32_dpp %0, %1 row_ror:15 row_mask:0xf bank_mask:0xf" : "=v"(r) : "v"(v)); return r; }
__device__ __forceinline__ f32x4 ror4(f32x4 v) { return (f32x4){dpp_ror1(v[0]), dpp_ror1(v[1]), dpp_ror1(v[2]), dpp_ror1(v[3])}; }
__device__ __forceinline__ f32x4 rol4(f32x4 v) { return (f32x4){dpp_rol1(v[0]), dpp_rol1(v[1]), dpp_rol1(v[2]), dpp_rol1(v[3])}; }
__device__ __forceinline__ void dpp_rot8(f32x4& pv, f32x4& nx, const f32x4& sp, const f32x4& sn) {
    float p0, p1, p2, p3, n0, n1, n2, n3;
    asm volatile("s_nop 1\n\t"
                 "v_mov_b32_dpp %0, %8 row_ror:1 row_mask:0xf bank_mask:0xf\n\t"
                 "v_mov_b32_dpp %1, %9 row_ror:1 row_mask:0xf bank_mask:0xf\n\t"
                 "v_mov_b32_dpp %2, %10 row_ror:1 row_mask:0xf bank_mask:0xf\n\t"
                 "v_mov_b32_dpp %3, %11 row_ror:1 row_mask:0xf bank_mask:0xf\n\t"
                 "v_mov_b32_dpp %4, %12 row_ror:15 row_mask:0xf bank_mask:0xf\n\t"
                 "v_mov_b32_dpp %5, %13 row_ror:15 row_mask:0xf bank_mask:0xf\n\t"
                 "v_mov_b32_dpp %6, %14 row_ror:15 row_mask:0xf bank_mask:0xf\n\t"
                 "v_mov_b32_dpp %7, %15 row_ror:15 row_mask:0xf bank_mask:0xf"
                 : "=&v"(p0), "=&v"(p1), "=&v"(p2), "=&v"(p3), "=&v"(n0), "=&v"(n1), "=&v"(n2), "=&v"(n3)
                 : "v"(sp[0]), "v"(sp[1]), "v"(sp[2]), "v"(sp[3]), "v"(sn[0]), "v"(sn[1]), "v"(sn[2]), "v"(sn[3]));
    pv = (f32x4){p0, p1, p2, p3}; nx = (f32x4){n0, n1, n2, n3};
}
__device__ __forceinline__ f32x4 fma4(f32x4 a, f32x4 b, f32x4 c) { return (f32x4){__builtin_fmaf(a[0], b[0], c[0]), __builtin_fmaf(a[1], b[1], c[1]), __builtin_fmaf(a[2], b[2], c[2]), __builtin_fmaf(a[3], b[3], c[3])}; }
struct EpiConvGlu {
    static constexpr bool PERM = true, AFTER_DRAIN = false;
    bf16_t* act; float* halo; const float* ssq_in; const float* cw; const float* cb; LAS unsigned char* xl;
    __device__ __forceinline__ void operator()(f32x4 (&acc)[2][2][4][2], const Unit& u, int wr, int wc, int fr, int fq) const {
        const int row0 = u.pm * BM + wr * 64 + fr, cc0 = wc * 32 + 8 * fq;
#pragma unroll
        for (int ai = 0; ai < 2; ++ai)
#pragma unroll
            for (int m = 0; m < 4; ++m) {
                const float rs = __builtin_amdgcn_rsqf(ssq_in[row0 + ai * HALF + m * 16] * (1.0f / DM) + EPS);
#pragma unroll
                for (int bj = 0; bj < 2; ++bj)
#pragma unroll
                    for (int n = 0; n < 2; ++n) acc[ai][bj][m][n] = acc[ai][bj][m][n] * rs;
            }
#ifndef NO_CONV2
        LAS float* XF = (LAS float*)xl;
        LAS float* XL = (LAS float*)(xl + 4096);
#pragma unroll
        for (int ai = 0; ai < 2; ++ai) {
            const int run = ai * 2 + wr;
#pragma unroll
            for (int bj = 0; bj < 2; ++bj)
#pragma unroll
                for (int n = 0; n < 2; ++n) {
                    const int col = bj * HALF + cc0 + 4 * n;
                    if (fr == 0) *(LAS f32x4*)(XF + run * 256 + col) = acc[ai][bj][0][n];
                    if (fr == 15) *(LAS f32x4*)(XL + run * 256 + col) = acc[ai][bj][3][n];
                }
        }
        {
            float* hb = halo + (size_t)u.pm * 4 * NUP + (size_t)u.pn * BM;
            if (wr == 0 && fr < 2) {
#pragma unroll
                for (int bj = 0; bj < 2; ++bj)
#pragma unroll
                    for (int n = 0; n < 2; ++n) *(f32x4*)(hb + (size_t)fr * NUP + bj * HALF + cc0 + 4 * n) = acc[0][bj][0][n];
            }
            if (wr == 1 && fr >= 14) {
#pragma unroll
                for (int bj = 0; bj < 2; ++bj)
#pragma unroll
                    for (int n = 0; n < 2; ++n) *(f32x4*)(hb + (size_t)(fr - 12) * NUP + bj * HALF + cc0 + 4 * n) = acc[1][bj][3][n];
            }
        }
        asm volatile("s_waitcnt lgkmcnt(0)" ::: "memory"); __builtin_amdgcn_s_barrier(); asm volatile("" ::: "memory");
#else
        LAS float* XF = (LAS float*)xl; LAS float* XL = (LAS float*)(xl + 4096);
#endif
#ifndef NO_CONV3
        const int chbase = u.pn * HALF + cc0;
#pragma unroll
        for (int bj = 0; bj < 2; ++bj) {
#pragma unroll
            for (int n = 0; n < 2; ++n) {
                const int ch = bj * DFF + chbase + 4 * n, col = bj * HALF + cc0 + 4 * n;
                const f32x4 w0 = *(const f32x4*)(cw + ch), w1 = *(const f32x4*)(cw + NUP + ch), w2 = *(const f32x4*)(cw + 2 * NUP + ch), bb = *(const f32x4*)(cb + ch);
#pragma unroll
                for (int ai = 0; ai < 2; ++ai) {
                    const int run = ai * 2 + wr;
                    f32x4 hp = {0.f, 0.f, 0.f, 0.f}, hn = {0.f, 0.f, 0.f, 0.f};
                    if (run > 0) hp = *(const LAS f32x4*)(XL + (run - 1) * 256 + col);
                    if (run < 3) hn = *(const LAS f32x4*)(XF + (run + 1) * 256 + col);
                    f32x4 pv[4], nx[4];
#pragma unroll
                    for (int m = 0; m < 4; ++m) {
                        const f32x4 old = acc[ai][bj][m][n];
                        const f32x4 below = (m > 0) ? acc[ai][bj][m > 0 ? m - 1 : 0][n] : hp;
                        const f32x4 above = (m < 3) ? acc[ai][bj][m < 3 ? m + 1 : 3][n] : hn;
                        dpp_rot8(pv[m], nx[m], (fr == 15) ? below : old, (fr == 0) ? above : old);
                    }
#pragma unroll
                    for (int m = 0; m < 4; ++m) acc[ai][bj][m][n] = fma4(w2, nx[m], fma4(w1, acc[ai][bj][m][n], fma4(w0, pv[m], bb)));
                    asm volatile("" : "+v"(acc[ai][bj][0][n]), "+v"(acc[ai][bj][1][n]), "+v"(acc[ai][bj][2][n]), "+v"(acc[ai][bj][3][n]));
                    __builtin_amdgcn_sched_barrier(0);
                }
            }
        }
#else
        const int chbase = u.pn * HALF + cc0;
#endif
#pragma unroll
        for (int ai = 0; ai < 2; ++ai)
#pragma unroll
            for (int m = 0; m < 4; ++m) {
                const int row = row0 + ai * HALF + m * 16;
                f32x4 o[2];
#pragma unroll
                for (int n = 0; n < 2; ++n) { const f32x4 gq = acc[ai][0][m][n], uq = acc[ai][1][m][n];
#pragma unroll
                    for (int j = 0; j < 4; ++j) o[n][j] = gq[j] * __builtin_amdgcn_rcpf(1.0f + __builtin_amdgcn_exp2f(gq[j] * (-LOG2E))) * uq[j]; }
                *(u32x4*)(act + (size_t)row * DFF + chbase) = pack8(o[0], o[1]);
            }
    }
};

template <class Epi, class Sched, bool ALIGN_EPI = false, bool SP2 = false>
__device__ __forceinline__ void gemm_phase(LAS unsigned char* lds, const Gemm g, const Sched& S, const Epi& E, int tid_bias = 0) {
    const int wid = __builtin_amdgcn_readfirstlane((int)(threadIdx.x >> 6)) + tid_bias, lane = fresh_lane(), tid = wid * 64 + lane, wr = wid >> 2, wc = wid & 3, fr = lane & 15, fq = lane >> 4;
    const int K = g.K, nt = K / BK;
    unsigned voffA[2], voffB[2];
#pragma unroll
    for (int i = 0; i < 2; ++i) { int R, C; stage_rc(tid * 16 + i * 8192, R, C); const int Rb = Epi::PERM ? ((R & ~31) + perm32(R & 31)) : R;
        voffA[i] = (unsigned)(R * K + C) * 2u; voffB[i] = (unsigned)(Rb * K + C) * 2u; }
    const size_t kstep = (size_t)(BK * 2);
    const size_t hstep = (size_t)HALF * K * 2;
    const size_t tstep = 2 * hstep;
    const unsigned ldsw = (unsigned)wid * 1024u;
    const int aoff = lds_byte(wr * 64 + fr, fq * 8), boff = lds_byte(wc * 32 + fr, fq * 8);
#define PG8_SA(b, h) (((b) * 2 + (h)) * HTB)
#define PG8_SB(b, h) ((4 + (b) * 2 + (h)) * HTB)
#define PG8_STAGE(bufoff, gbase, voff) do { _Pragma("unroll") for (int _i = 0; _i < 2; ++_i) \
        __builtin_amdgcn_global_load_lds((const unsigned*)((const char*)(gbase) + (voff)[_i]), (LAS unsigned*)(lds + (bufoff) + ldsw + _i * 8192), 16, 0, 0); } while (0)
#define PG8_LDA(dst, b, h) do { _Pragma("unroll") for (int m = 0; m < 4; ++m) _Pragma("unroll") for (int k = 0; k < 2; ++k) dst[m][k] = *(const LAS bf16x8*)(lds + PG8_SA(b, h) + aoff + m * 2048 + k * 1024); } while (0)
#define PG8_LDB(dst, b, h) do { _Pragma("unroll") for (int n = 0; n < 2; ++n) _Pragma("unroll") for (int k = 0; k < 2; ++k) dst[n][k] = *(const LAS bf16x8*)(lds + PG8_SB(b, h) + boff + n * 2048 + k * 1024); } while (0)
#define PG8_MMA(ai, bj, At, Bt) do { __builtin_amdgcn_s_setprio(1); _Pragma("unroll") for (int m = 0; m < 4; ++m) _Pragma("unroll") for (int n = 0; n < 2; ++n) _Pragma("unroll") for (int k = 0; k < 2; ++k) \
        acc[ai][bj][m][n] = __builtin_amdgcn_mfma_f32_16x16x32_bf16(Bt[n][k], At[m][k], acc[ai][bj][m][n], 0, 0, 0); __builtin_amdgcn_s_setprio(0); } while (0)
#define PG8_WAIT_V(n) asm volatile("s_waitcnt vmcnt(" #n ")" ::: "memory")
#define PG8_WAIT_L(n) asm volatile("s_waitcnt lgkmcnt(" #n ")" ::: "memory")
#define PG8_BAR __builtin_amdgcn_s_barrier()
#define PG8_SCHED __builtin_amdgcn_sched_barrier(0)
    Unit cur, nxt; int ui = 0;
    if (!S.next(0, cur)) return;
    f32x4 acc[2][2][4][2];
#pragma unroll
    for (int a = 0; a < 2; ++a)
#pragma unroll
        for (int b = 0; b < 2; ++b)
#pragma unroll
            for (int m = 0; m < 4; ++m)
#pragma unroll
                for (int n = 0; n < 2; ++n) acc[a][b][m][n] = (f32x4){0.f, 0.f, 0.f, 0.f};
    bf16x8 At[4][2], B0[2][2], B1[2][2];
    const char* cA = (const char*)g.A + (size_t)cur.pm * tstep; const char* cB = (const char*)g.Bt + (size_t)cur.pn * tstep;
    S.a_ready(cur);
    if constexpr (SP2) {
        PG8_STAGE(PG8_SB(0, 0), cB, voffB); PG8_STAGE(PG8_SB(0, 1), cB + hstep, voffB); PG8_STAGE(PG8_SA(0, 0), cA, voffA); PG8_STAGE(PG8_SA(0, 1), cA + hstep, voffA);
        if (wr == 1) PG8_BAR;
        PG8_WAIT_V(2); PG8_BAR;
        PG8_STAGE(PG8_SB(1, 0), cB + kstep, voffB); PG8_STAGE(PG8_SA(1, 0), cA + kstep, voffA); PG8_STAGE(PG8_SB(1, 1), cB + hstep + kstep, voffB);
        PG8_WAIT_V(6); PG8_BAR;
    } else {
        PG8_STAGE(PG8_SB(0, 0), cB, voffB); PG8_STAGE(PG8_SA(0, 0), cA, voffA); PG8_STAGE(PG8_SB(0, 1), cB + hstep, voffB); PG8_STAGE(PG8_SA(0, 1), cA + hstep, voffA);
        if (wr == 1) PG8_BAR;
        PG8_WAIT_V(4); PG8_BAR;
        PG8_STAGE(PG8_SB(1, 0), cB + kstep, voffB); PG8_STAGE(PG8_SA(1, 0), cA + kstep, voffA); PG8_STAGE(PG8_SB(1, 1), cB + hstep + kstep, voffB);
        PG8_WAIT_V(6); PG8_BAR;
    }
    for (;;) {
        const bool has_next = S.next(ui + 1, nxt);
        const char* nA = has_next ? (const char*)g.A + (size_t)nxt.pm * tstep : cA; const char* nB = has_next ? (const char*)g.Bt + (size_t)nxt.pn * tstep : cB;
        for (int t = 0; t < nt; t += 2) {
            const bool last = (t == nt - 2);
            const char* a1 = cA + (size_t)(t + 1) * kstep;
            const char* a2 = last ? nA : cA + (size_t)(t + 2) * kstep; const char* b2 = last ? nB : cB + (size_t)(t + 2) * kstep;
            const char* a3 = a2 + kstep; const char* b3 = b2 + kstep;
            if (last && has_next) S.a_ready(nxt);
            if constexpr (SP2) {
            PG8_LDB(B0, 0, 0); PG8_LDB(B1, 0, 1); PG8_SCHED; PG8_LDA(At, 0, 0); PG8_STAGE(PG8_SA(1, 1), a1 + hstep, voffA);
            PG8_WAIT_V(8); PG8_WAIT_L(0); PG8_BAR; PG8_MMA(0, 0, At, B0); PG8_MMA(0, 1, At, B1); PG8_BAR; PG8_SCHED;
            PG8_LDA(At, 0, 1); PG8_STAGE(PG8_SB(0, 0), b2, voffB); PG8_STAGE(PG8_SB(0, 1), b2 + hstep, voffB); PG8_STAGE(PG8_SA(0, 0), a2, voffA);
            PG8_WAIT_V(8); PG8_WAIT_L(0); PG8_BAR; PG8_MMA(1, 0, At, B0); PG8_MMA(1, 1, At, B1); PG8_BAR; PG8_SCHED;
            PG8_LDB(B0, 1, 0); PG8_LDB(B1, 1, 1); PG8_SCHED; PG8_LDA(At, 1, 0); PG8_STAGE(PG8_SA(0, 1), a2 + hstep, voffA);
            PG8_WAIT_V(8); PG8_WAIT_L(0); PG8_BAR; PG8_MMA(0, 0, At, B0); PG8_MMA(0, 1, At, B1); PG8_BAR; PG8_SCHED;
            PG8_LDA(At, 1, 1); PG8_STAGE(PG8_SB(1, 0), b3, voffB); PG8_STAGE(PG8_SB(1, 1), b3 + hstep, voffB); PG8_STAGE(PG8_SA(1, 0), a3, voffA);
            PG8_WAIT_V(8); PG8_WAIT_L(0); PG8_BAR; PG8_MMA(1, 0, At, B0); PG8_MMA(1, 1, At, B1); PG8_BAR; PG8_SCHED;
            } else {
            PG8_LDB(B0, 0, 0); PG8_SCHED; PG8_LDA(At, 0, 0); PG8_STAGE(PG8_SA(1, 1), a1 + hstep, voffA);
            PG8_WAIT_L(8); PG8_BAR; PG8_WAIT_L(0); PG8_MMA(0, 0, At, B0); PG8_BAR; PG8_SCHED;
            PG8_LDB(B1, 0, 1); PG8_STAGE(PG8_SB(0, 0), b2, voffB);
            PG8_BAR; PG8_WAIT_L(0); PG8_MMA(0, 1, At, B1); PG8_BAR;
            PG8_LDA(At, 0, 1); PG8_STAGE(PG8_SA(0, 0), a2, voffA);
            PG8_BAR; PG8_WAIT_L(0); PG8_MMA(1, 0, At, B0); PG8_BAR; PG8_SCHED;
            PG8_STAGE(PG8_SB(0, 1), b2 + hstep, voffB);
            PG8_WAIT_V(6); PG8_BAR; PG8_MMA(1, 1, At, B1); PG8_BAR;
            PG8_LDB(B0, 1, 0); PG8_SCHED; PG8_LDA(At, 1, 0); PG8_STAGE(PG8_SA(0, 1), a2 + hstep, voffA);
            PG8_WAIT_L(8); PG8_BAR; PG8_WAIT_L(0); PG8_MMA(0, 0, At, B0); PG8_BAR; PG8_SCHED;
            PG8_LDB(B1, 1, 1); PG8_STAGE(PG8_SB(1, 0), b3, voffB);
            PG8_BAR; PG8_WAIT_L(0); PG8_MMA(0, 1, At, B1); PG8_BAR;
            PG8_LDA(At, 1, 1); PG8_STAGE(PG8_SA(1, 0), a3, voffA);
            PG8_BAR; PG8_WAIT_L(0); PG8_MMA(1, 0, At, B0); PG8_BAR; PG8_SCHED;
            PG8_STAGE(PG8_SB(1, 1), b3 + hstep, voffB);
            PG8_WAIT_V(6); PG8_BAR; PG8_MMA(1, 1, At, B1); PG8_BAR;
            }
        }
        if constexpr (ALIGN_EPI) { if (wr == 0) PG8_BAR; }
        if constexpr (!Epi::AFTER_DRAIN) { const int l2 = fresh_lane(); E(acc, cur, wr, wc, l2 & 15, l2 >> 4); S.done(cur); }
        if (!has_next) break;
#pragma unroll
        for (int a = 0; a < 2; ++a)
#pragma unroll
            for (int b = 0; b < 2; ++b)
#pragma unroll
                for (int m = 0; m < 4; ++m)
#pragma unroll
                    for (int n = 0; n < 2; ++n) acc[a][b][m][n] = (f32x4){0.f, 0.f, 0.f, 0.f};
        cur = nxt; cA = nA; cB = nB; ++ui;
        if constexpr (ALIGN_EPI) { if (wr == 1) PG8_BAR; }
    }
    PG8_WAIT_V(0);
    if constexpr (!ALIGN_EPI) { if (wr == 0) PG8_BAR; }
    PG8_BAR;
#undef PG8_SA
#undef PG8_SB
#undef PG8_STAGE
#undef PG8_LDA
#undef PG8_LDB
#undef PG8_MMA
#undef PG8_WAIT_V
#undef PG8_WAIT_L
#undef PG8_BAR
#undef PG8_SCHED
}
}

#define XB_TMO      128
#define XB_XCNT(j)  (256  + 64 * (j))
#define XB_XSUB(j)  (1280 + 64 * (j))
#define XB_XGEN(j)  (2304 + 64 * (j))
#define XB_TOP      3328
#define XB_TOPGEN   3392
#define XCD_BAR_WORDS 3456
#define XB_SPIN_CAP (1u << 18)
__device__ __forceinline__ unsigned xb_ld(unsigned* p)              { return __hip_atomic_load(p, __ATOMIC_RELAXED, __HIP_MEMORY_SCOPE_AGENT); }
__device__ __forceinline__ unsigned xb_add(unsigned* p, unsigned v) { return __hip_atomic_fetch_add(p, v, __ATOMIC_RELAXED, __HIP_MEMORY_SCOPE_AGENT); }
__device__ __forceinline__ unsigned xb_xcc_id() { return (unsigned)__builtin_amdgcn_s_getreg((3 << 11) | 20) & 0xFu; }
#define XB_SPIN(cond, bar) do { unsigned _sp = 0; while (cond) { __builtin_amdgcn_s_sleep(1); \
    if ((++_sp & 255u) == 0u) { if (xb_ld(&(bar)[XB_TMO])) break; if (_sp > XB_SPIN_CAP) { atomicAdd(&(bar)[XB_TMO], 1u); break; } } } } while (0)
struct XcdBarrier { unsigned* bar; unsigned x; volatile LAS unsigned* st; };
__device__ __forceinline__ XcdBarrier xcd_barrier_post(unsigned* bar, volatile LAS unsigned* st) {
    XcdBarrier b; b.bar = bar; b.x = xb_xcc_id(); b.st = st;
    if (threadIdx.x == 0) (void)xb_add(&bar[XB_XCNT(b.x)], 1u);
    return b;
}
__device__ __forceinline__ void xcd_barrier_complete(unsigned* bar, unsigned x, unsigned& nloc, unsigned& nx) {
    const unsigned G = gridDim.x * gridDim.y * gridDim.z;
    unsigned sum, cnt, mine, sp = 0u;
    for (;;) {
        sum = 0u; cnt = 0u; mine = 0u;
#pragma unroll
        for (unsigned j = 0; j < 16; ++j) { const unsigned c = xb_ld(&bar[XB_XCNT(j)]); sum += c; cnt += (c > 0u) ? 1u : 0u; mine = (j == x) ? c : mine; }
        if (sum == G) break;
        __builtin_amdgcn_s_sleep(1);
        if ((++sp & 255u) == 0u) { if (xb_ld(&bar[XB_TMO])) break; if (sp > XB_SPIN_CAP) { atomicAdd(&bar[XB_TMO], 1u); break; } }
    }
    nloc = mine > 0u ? mine : 1u; nx = cnt > 0u ? cnt : 1u;
}
__device__ __forceinline__ void xcd_barrier(const XcdBarrier& b) {
    asm volatile("s_waitcnt vmcnt(0)" ::: "memory");
    __syncthreads();
    if (threadIdx.x == 0) {
        unsigned* bar = b.bar;
        __builtin_amdgcn_s_waitcnt(0);
        unsigned nloc = b.st[0], nx = b.st[1];
        if (nloc == 0u) { xcd_barrier_complete(bar, b.x, nloc, nx); b.st[0] = nloc; b.st[1] = nx; }
        const unsigned old = xb_add(&bar[XB_XSUB(b.x)], 1u);
        const unsigned gen = old / nloc;
        if (old + 1u == (gen + 1u) * nloc) {
            __builtin_amdgcn_fence(__ATOMIC_RELEASE, "agent");
            asm volatile("s_waitcnt vmcnt(0)" ::: "memory");
            const unsigned og = xb_add(&bar[XB_TOP], 1u);
            const unsigned tg = og / nx;
            if (og + 1u == (tg + 1u) * nx) xb_add(&bar[XB_TOPGEN], 1u);
            else XB_SPIN(xb_ld(&bar[XB_TOPGEN]) == tg, bar);
            __builtin_amdgcn_fence(__ATOMIC_ACQUIRE, "agent");
            xb_add(&bar[XB_XGEN(b.x)], 1u);
            asm volatile("s_waitcnt vmcnt(0)" ::: "memory");
        } else {
            XB_SPIN(xb_ld(&bar[XB_XGEN(b.x)]) == gen, bar);
            __builtin_amdgcn_fence(__ATOMIC_ACQUIRE, "agent");
            asm volatile("s_waitcnt vmcnt(0)" ::: "memory");
        }
    }
    __syncthreads();
}

struct Frame {
    LAS unsigned char* lds;
    int tid, lane, wave, vcu, G;
    const float *x, *p; const int* pos;
    const float *g_mix, *w_in, *lq1, *lk1, *lq2, *lk2, *g_subln, *ln_g, *ln_b, *w_sp, *b_sp, *w_out, *g_ffn, *w_up, *conv_w, *conv_b, *w_down, *g_ple, *w_gate, *w_pup, *g_final;
    float* out; unsigned char* ws;
};

__device__ __forceinline__ void conv_load(const float* W, int N, int item, int lane, f32x4 (&v)[16]) {
    const int nblk = N / 64, kb = item / nblk, nb = item % nblk, k0 = 64 * kb, n0 = 64 * nb;
    const int lr = lane >> 4, lc = (lane & 15) * 4;
    const float* src = W + (size_t)(k0 + lr) * N + n0 + lc;
#pragma unroll
    for (int i = 0; i < 16; ++i) v[i] = __builtin_nontemporal_load((const f32x4*)(src + (size_t)(4 * i) * N));
}
template <int MODE>
__device__ __forceinline__ void conv_store(f32x4 (&v)[16], int K, int N, bf16_t* WT, LAS float* scr, int item, int lane, const float* gk = nullptr) {
    const int nblk = N / 64, kb = item / nblk, nb = item % nblk, k0 = 64 * kb, n0 = 64 * nb;
    const int lr = lane >> 4, lc = (lane & 15) * 4;
#pragma unroll
    for (int i = 0; i < 16; ++i) { if (gk) v[i] = v[i] * gk[k0 + 4 * i + lr];
        LAS float* d = scr + (4 * i + lr) * 65 + lc; d[0] = v[i][0]; d[1] = v[i][1]; d[2] = v[i][2]; d[3] = v[i][3]; }
    LDS_WAIT(); asm volatile("" ::: "memory");
    int r0 = n0;
    if (MODE == 1) { const int isu = n0 >= DFF ? 1 : 0, ch = n0 - isu * DFF; r0 = (ch >> 7) * 256 + isu * 128 + (ch & 127); }
    const int c = lane & 7;
#pragma unroll
    for (int j = 0; j < 8; ++j) { const int n = (lane >> 3) + 8 * j; const LAS float* sp = scr + (8 * c) * 65 + n;
        u32x4 o; o.x = pk2(sp[0], sp[65]); o.y = pk2(sp[2 * 65], sp[3 * 65]); o.z = pk2(sp[4 * 65], sp[5 * 65]); o.w = pk2(sp[6 * 65], sp[7 * 65]);
        *(u32x4*)(WT + (size_t)(r0 + n) * K + k0 + 8 * c) = o; }
    LDS_WAIT(); asm volatile("" ::: "memory");
}
template <int MODE>
__device__ __forceinline__ void conv_item(const float* W, int K, int N, bf16_t* WT, LAS float* scr, int item, int lane, const float* gk = nullptr) {
    f32x4 v[16]; conv_load(W, N, item, lane, v); conv_store<MODE>(v, K, N, WT, scr, item, lane, gk);
}
template <int MODE>
__device__ __forceinline__ void conv_pair(const float* W, int K, int N, bf16_t* WT, LAS float* scr, int item, int lane, const float* gk = nullptr) {
    f32x4 va[16], vb[16]; conv_load(W, N, item, lane, va); conv_load(W, N, item + 1, lane, vb);
    conv_store<MODE>(va, K, N, WT, scr, item, lane, gk); conv_store<MODE>(vb, K, N, WT, scr, item + 1, lane, gk);
}
constexpr int IT_OUT = (DM / 64) * (DM / 64), IT_UP = (DM / 64) * (NUP / 64), IT_DN = (DFF / 64) * (DM / 64), IT_G = IT_OUT;
constexpr int SEG_A_ITEMS = IT_OUT + IT_UP, SEG_B_ITEMS = IT_DN + IT_G;
__device__ __forceinline__ unsigned q_ld(unsigned* p) { return __hip_atomic_load(p, __ATOMIC_RELAXED, __HIP_MEMORY_SCOPE_AGENT); }
__device__ __forceinline__ unsigned q_add(unsigned* p, unsigned v) { return __hip_atomic_fetch_add(p, v, __ATOMIC_RELAXED, __HIP_MEMORY_SCOPE_AGENT); }
__device__ __forceinline__ void conv_drain(Frame& F, int seg, unsigned done_target) {
    LAS float* scr = (LAS float*)(F.lds + F.wave * CONV_LDS_PER_WAVE);
    unsigned char* ws = F.ws; unsigned* ctl = (unsigned*)(ws + WS_CTL);
    unsigned* q = ctl + (seg ? CW_QB : CW_QA); unsigned* dn = ctl + (seg ? CW_DONE4 : CW_DONE1);
    const int nit = seg ? SEG_B_ITEMS : SEG_A_ITEMS, per = nit / 8;
    const int home = (int)(blockIdx.x & 7);
    for (int ss = 0; ss < 8; ++ss) {
        const int sh = (home + ss) & 7; unsigned* qh = q + 64 * sh;
        for (;;) {
            if (done_target) { if ((unsigned)__builtin_amdgcn_readfirstlane((int)q_ld(dn)) >= done_target) return; }
            if ((int)__builtin_amdgcn_readfirstlane((int)q_ld(qh)) >= per) break;
            unsigned i0 = 0; if (F.lane == 0) i0 = q_add(qh, 2u);
            i0 = (unsigned)__builtin_amdgcn_readfirstlane((int)i0);
            if ((int)i0 >= per) break;
            { const int it = sh * per + (int)i0;
                if (seg == 0) { if (it < IT_OUT) conv_pair<0>(F.w_out, DM, DM, (bf16_t*)(ws + WS_WOUTT), scr, it, F.lane); else conv_pair<1>(F.w_up, DM, NUP, (bf16_t*)(ws + WS_WUPT), scr, it - IT_OUT, F.lane, F.g_ffn); }
                else { if (it < IT_DN) conv_pair<0>(F.w_down, DFF, DM, (bf16_t*)(ws + WS_WDT), scr, it, F.lane); else conv_pair<0>(F.w_gate, DM, DM, (bf16_t*)(ws + WS_WGT), scr, it - IT_DN, F.lane, F.g_ple); } }
        }
    }
}
static_assert(SEG_A_ITEMS % 16 == 0 && SEG_B_ITEMS % 16 == 0 && IT_OUT % 2 == 0 && IT_DN % 2 == 0, "queue shards / item pairs");
__device__ __forceinline__ void p0_prologue(Frame& F) {
    LAS float* scr = (LAS float*)(F.lds + F.wave * CONV_LDS_PER_WAVE);
    const int gw = F.vcu * 8 + F.wave, NGW = F.G * 8;
    unsigned char* ws = F.ws;
    constexpr int I_IN = (DM / 64) * (NIN / 64), I_PU = (PLE / 64) * (DM / 64);
    for (int it = gw; it < I_IN + I_PU; it += 2 * NGW) {
        const int it2 = it + NGW; const bool two = it2 < I_IN + I_PU;
        f32x4 va[16], vb[16];
        if (it < I_IN) conv_load(F.w_in, NIN, it, F.lane, va); else conv_load(F.w_pup, DM, it - I_IN, F.lane, va);
        if (two) { if (it2 < I_IN) conv_load(F.w_in, NIN, it2, F.lane, vb); else conv_load(F.w_pup, DM, it2 - I_IN, F.lane, vb); }
        if (it < I_IN) conv_store<0>(va, DM, NIN, (bf16_t*)(ws + WS_WINT), scr, it, F.lane); else conv_store<0>(va, PLE, DM, (bf16_t*)(ws + WS_WPUT), scr, it - I_IN, F.lane);
        if (two) { if (it2 < I_IN) conv_store<0>(vb, DM, NIN, (bf16_t*)(ws + WS_WINT), scr, it2, F.lane); else conv_store<0>(vb, PLE, DM, (bf16_t*)(ws + WS_WPUT), scr, it2 - I_IN, F.lane); }
    }
    bf16_t* A0 = (bf16_t*)(ws + WS_A);
    {
        f32x4 v[8], nv[8];
        int m = gw;
        if (m < MTOK) { const f32x4* xr = (const f32x4*)(F.x + (size_t)m * DM) + F.lane;
#pragma unroll
            for (int j = 0; j < 8; ++j) nv[j] = __builtin_nontemporal_load(xr + 64 * j); }
        for (; m < MTOK; m += NGW) {
#pragma unroll
            for (int j = 0; j < 8; ++j) v[j] = nv[j];
            if (m + NGW < MTOK) { const f32x4* xr = (const f32x4*)(F.x + (size_t)(m + NGW) * DM) + F.lane;
#pragma unroll
                for (int j = 0; j < 8; ++j) nv[j] = __builtin_nontemporal_load(xr + 64 * j); }
            float s = 0.f;
#pragma unroll
            for (int j = 0; j < 8; ++j) s += pg8::dot4(v[j]);
            const float sd = sqrtf(wave_sum(s) * (1.0f / DM) + EPS), rstd = 1.0f / sd;
            if (F.lane == 0) ((float*)(ws + WS_SSQ))[3 * MTOK + m] = sd;
            u32x2* o8 = (u32x2*)(A0 + (size_t)m * DM) + F.lane;
#pragma unroll
            for (int j = 0; j < 8; ++j) { const f32x4 gq = *((const f32x4*)F.g_mix + F.lane + 64 * j); const f32x4 y = v[j] * rstd * gq; u32x2 w; w.x = pk2(y[0], y[1]); w.y = pk2(y[2], y[3]); o8[64 * j] = w; }
        }
    }
    {
        const int gt = F.vcu * 512 + F.tid, NGT = F.G * 512;
        bf16_t* PB = (bf16_t*)(ws + WS_PB);
        for (int i = gt; i < MTOK * PLE / 4; i += NGT) { const f32x4 v = __builtin_nontemporal_load((const f32x4*)F.p + i); u32x2 w; w.x = pk2(v[0], v[1]); w.y = pk2(v[2], v[3]); *((u32x2*)PB + i) = w; }
        float* rope = (float*)(ws + WS_ROPE);
        for (int i = gt; i < MTOK * 8; i += NGT) {
            const int row = i >> 3, fi = i & 7;
            const float invf = (float)exp2(-(double)fi * (18.931568569324174 / 8.0));
            const float ang = (float)F.pos[row] * invf;
            const double a = (double)ang, kq = rint(a * 0.63661977236758134);
            const double r = fma(-kq, 1.5707963267948966, a) - kq * 6.123233995736766e-17;
            const double r2 = r * r;
            const double sn = r + r * r2 * (-1.0 / 6 + r2 * (1.0 / 120 + r2 * (-1.0 / 5040 + r2 * (1.0 / 362880 + r2 * (-1.0 / 39916800)))));
            const double cs = 1.0 + r2 * (-0.5 + r2 * (1.0 / 24 + r2 * (-1.0 / 720 + r2 * (1.0 / 40320 + r2 * (-1.0 / 3628800 + r2 * (1.0 / 479001600))))));
            const int qd = ((int)kq) & 3;
            const double sv = (qd == 0) ? sn : (qd == 1) ? cs : (qd == 2) ? -sn : -cs;
            const double cv = (qd == 0) ? cs : (qd == 1) ? -sn : (qd == 2) ? -cs : sn;
            rope[(size_t)row * 16 + fi] = (float)cv; rope[(size_t)row * 16 + 8 + fi] = (float)sv;
        }
        float* ssq = (float*)(ws + WS_SSQ);
        for (int i = gt; i < 3 * MTOK; i += NGT) ssq[i] = 0.f;
    }
}

__device__ __forceinline__ int crow(int r, int hi) { return (r & 3) + 8 * (r >> 2) + 4 * hi; }
__device__ __forceinline__ s16x4 vtr(const LAS unsigned char* p) { typedef short v4i16_t __attribute__((ext_vector_type(4))); return __builtin_bit_cast(s16x4, __builtin_amdgcn_ds_read_tr16_b64_v4i16((LAS v4i16_t*)p)); }
#define MF32(a, b, c) __builtin_amdgcn_mfma_f32_32x32x16_bf16((a), (b), (c), 0, 0, 0)
__device__ __forceinline__ void glds16(const void* gsrc, unsigned lds_dst) { unsigned keep;
    asm volatile("s_mov_b32 %0, m0\n\ts_mov_b32 m0, %2\n\ts_nop 0\n\tglobal_load_lds_dwordx4 %1, off\n\ts_mov_b32 m0, %0" : "=&s"(keep) : "v"(gsrc), "s"(lds_dst) : "memory"); }
constexpr float ATT_THR = 8.0f;
__device__ __forceinline__ float rowmax32(const f32x16& a, const f32x16& b) {
    float x = fmaxf(fmaxf(a[0], a[1]), a[2]), y = fmaxf(fmaxf(b[0], b[1]), b[2]);
#pragma unroll
    for (int r = 3; r < 15; r += 2) { x = fmaxf(fmaxf(x, a[r]), a[r + 1]); y = fmaxf(fmaxf(y, b[r]), b[r + 1]); }
    x = fmaxf(fmaxf(x, a[15]), fmaxf(y, b[15]));
    return fmaxf(x, __shfl_xor(x, 32));
}
__device__ __forceinline__ void att_qk(f32x16& n0, f32x16& n1, const LAS unsigned char* kb, const bf16x8 (&qr)[4]) {
    n0 = (f32x16){}; n1 = (f32x16){};
#pragma unroll
    for (int d0 = 0; d0 < 4; ++d0) {
        const bf16x8 a0 = *(const LAS bf16x8*)(kb + d0 * 2048), a1 = *(const LAS bf16x8*)(kb + d0 * 2048 + 512);
        n0 = MF32(a0, qr[d0], n0); n1 = MF32(a1, qr[d0], n1); }
}
__device__ __forceinline__ float fadd_s(float a, float b) { float r; asm("v_add_f32_e32 %0, %1, %2" : "=v"(r) : "v"(a), "v"(b)); return r; }
__device__ __forceinline__ float fmax3_s(float a, float b, float c) { float r; asm("v_max3_f32 %0, %1, %2, %3" : "=v"(r) : "v"(a), "v"(b), "v"(c)); return r; }
__device__ __forceinline__ float fmax_s(float a, float b) { float r; asm("v_max_f32_e32 %0, %1, %2" : "=v"(r) : "v"(a), "v"(b)); return r; }
#define ATT_SBAR() __builtin_amdgcn_sched_barrier(0)
#ifndef ATT_VPF
#define ATT_VPF 3
#endif
__device__ __forceinline__ u32x4 att_pack8(const f32x16& x, int b) { return (u32x4){pk2(x[b], x[b + 1]), pk2(x[b + 2], x[b + 3]), pk2(x[b + 4], x[b + 5]), pk2(x[b + 6], x[b + 7])}; }
template <bool TRACK, bool HAS_CUR, bool HAS_NEXT>
__device__ __forceinline__ void att_step(f32x16 (&o)[4], f32x16& e0, f32x16& e1, f32x16& c0, f32x16& c1, float& m, float& l, f32x16& negm,
                                         const bf16x8 (&qr)[4], const LAS unsigned char* kb_next, const LAS unsigned char* vb_prev, LAS float* wsf, int r32, int hi) {
    float mx0 = (TRACK && HAS_CUR) ? c0[0] : 0.f, mx1 = (TRACK && HAS_CUR) ? c1[0] : 0.f, s0 = e0[0], s1 = e1[0];
    {
        constexpr int VPF = TRACK ? 2 : ATT_VPF, NB = VPF + 1;
        s16x4 flo[NB], fhi[NB]; u32x4 pw;
#define ATT_VRD(i, slot) do { flo[slot] = vtr(vb_prev + ((((i) & 3) * 4) + ((i) >> 2)) * 1024); fhi[slot] = vtr(vb_prev + ((((i) & 3) * 4) + ((i) >> 2)) * 1024 + 512); } while (0)
#pragma unroll
        for (int i = 0; i < VPF; ++i) ATT_VRD(i, i);
#pragma unroll
        for (int i = 0; i < 16; ++i) {
            if (i + VPF < 16) ATT_VRD(i + VPF, (i + VPF) % NB);
            if ((i & 3) == 0) { const int ks = i >> 2; pw = (ks < 2) ? att_pack8(e0, 8 * (ks & 1)) : att_pack8(e1, 8 * (ks & 1)); }
            const bf16x8 vf = (bf16x8){flo[i % NB][0], flo[i % NB][1], flo[i % NB][2], flo[i % NB][3], fhi[i % NB][0], fhi[i % NB][1], fhi[i % NB][2], fhi[i % NB][3]};
            o[i & 3] = MF32(__builtin_bit_cast(bf16x8, pw), vf, o[i & 3]);
            if (TRACK && i > 0) { s0 = fadd_s(s0, e0[i]); s1 = fadd_s(s1, e1[i]); }
            if (TRACK && HAS_CUR && i > 0) { if (i & 1) mx0 = fmax3_s(mx0, c0[i], c1[i]); else mx1 = fmax3_s(mx1, c0[i], c1[i]); }
            ATT_SBAR();
        }
#undef ATT_VRD
    }
    if (!TRACK) {
#pragma unroll
        for (int i = 1; i < 16; ++i) { s0 = fadd_s(s0, e0[i]); s1 = fadd_s(s1, e1[i]); }
    }
    l += s0 + s1;
    if (HAS_CUR) {
        float rm = fmaxf(mx0, mx1); if (TRACK) rm = fmaxf(rm, __shfl_xor(rm, 32));
        if (TRACK && __any(rm > ATT_THR)) {
            const float dl = fmaxf(rm, 0.f), alpha = __builtin_amdgcn_exp2f(-dl); m += dl; l *= alpha;
#pragma unroll
            for (int r = 0; r < 16; ++r) { c0[r] -= dl; c1[r] -= dl; negm[r] = -m; }
            if (hi == 0) wsf[r32] = alpha;
            LDS_WAIT();
#pragma unroll
            for (int r = 0; r < 16; ++r) { const float ar = wsf[crow(r, hi)];
#pragma unroll
                for (int d = 0; d < 4; ++d) o[d][r] *= ar; }
        }
        ATT_SBAR();
        if (HAS_NEXT) {
            bf16x8 ka[2], kc[2];
            ka[0] = *(const LAS bf16x8*)(kb_next); kc[0] = *(const LAS bf16x8*)(kb_next + 512);
#pragma unroll
            for (int d0 = 0; d0 < 4; ++d0) {
                if (d0 < 3) { ka[(d0 + 1) & 1] = *(const LAS bf16x8*)(kb_next + (d0 + 1) * 2048); kc[(d0 + 1) & 1] = *(const LAS bf16x8*)(kb_next + (d0 + 1) * 2048 + 512); }
                if (d0 == 0) e0 = MF32(ka[0], qr[0], negm); else e0 = MF32(ka[d0 & 1], qr[d0], e0);
#pragma unroll
                for (int r = 4 * d0; r < 4 * d0 + 4; ++r) c0[r] = __builtin_amdgcn_exp2f(c0[r]);
                ATT_SBAR();
                if (d0 == 0) e1 = MF32(kc[0], qr[0], negm); else e1 = MF32(kc[d0 & 1], qr[d0], e1);
#pragma unroll
                for (int r = 4 * d0; r < 4 * d0 + 4; ++r) c1[r] = __builtin_amdgcn_exp2f(c1[r]);
                ATT_SBAR();
            }
        } else {
#pragma unroll
            for (int r = 0; r < 16; ++r) { c0[r] = __builtin_amdgcn_exp2f(c0[r]); c1[r] = __builtin_amdgcn_exp2f(c1[r]); }
        }
        asm volatile("" : "+v"(c0), "+v"(c1));
        ATT_SBAR();
    }
}
__device__ __forceinline__ void att_qk_c(f32x16& n0, f32x16& n1, const LAS unsigned char* kb, const bf16x8 (&qr)[4], const f32x16& negm) {
#pragma unroll
    for (int d0 = 0; d0 < 4; ++d0) {
        const bf16x8 a0 = *(const LAS bf16x8*)(kb + d0 * 2048), a1 = *(const LAS bf16x8*)(kb + d0 * 2048 + 512);
        if (d0 == 0) { n0 = MF32(a0, qr[0], negm); n1 = MF32(a1, qr[0], negm); } else { n0 = MF32(a0, qr[d0], n0); n1 = MF32(a1, qr[d0], n1); } }
}
constexpr float ATT_HEADROOM = 64.0f;
#ifndef ATT_FAST_TRACK
#define ATT_FAST_TRACK false
#endif
template <bool TRACK>
__device__ __forceinline__ bool attn_unit(int b, int h, int qb, const bf16_t* Qg, const bf16_t* Kg, const bf16_t* Vg, bf16_t* MIX, const float* g_subln, float lam, LAS unsigned char* lds) {
    const int tid = threadIdx.x, lane = tid & 63, r32 = lane & 31, hi = lane >> 5;
    const int wid = __builtin_amdgcn_readfirstlane(tid >> 6), c = wid >> 2, wq = wid & 3;
    const size_t rowbase = (size_t)b * SEQ; const int q0 = qb * 128 + wq * 32;
    constexpr int NT = SEQ / 64;
    bf16x8 qr[4];
    { const bf16_t* qp = Qg + (rowbase + q0 + r32) * PARTW + h * 128 + c * 64 + hi * 8;
#pragma unroll
      for (int d0 = 0; d0 < 4; ++d0) qr[d0] = *(const bf16x8*)(qp + d0 * 16); }
    const bf16_t* ksrc = Kg + (rowbase + lane) * PARTW + h * 128;
    const bf16_t* vsrc = Vg + (rowbase + (lane >> 2)) * PARTW + h * 128 + (lane & 3) * 8;
    const unsigned lds0 = (unsigned)(uintptr_t)lds;
#define AT_KSLOT(s) ((s) * 16384)
#define AT_VSLOT(s) (49152 + (s) * 16384)
#define AT_DMA_K(t, s) do { _Pragma("unroll") for (int _i = 0; _i < 2; ++_i) { const int kc = wid + 8 * _i; \
        glds16(ksrc + (size_t)(t) * 64 * PARTW + kc * 8, (unsigned)__builtin_amdgcn_readfirstlane((int)(lds0 + AT_KSLOT(s) + kc * 1024))); } } while (0)
#define AT_DMA_V(t, s) do { _Pragma("unroll") for (int _i = 0; _i < 2; ++_i) { const int pi = wid + 8 * _i, d0v = pi >> 2, kg = pi & 3; \
        glds16(vsrc + ((size_t)(t) * 64 + kg * 16) * PARTW + d0v * 32, (unsigned)__builtin_amdgcn_readfirstlane((int)(lds0 + AT_VSLOT(s) + pi * 1024))); } } while (0)
#define AT_WAITBAR() do { asm volatile("s_waitcnt vmcnt(0) lgkmcnt(0)" ::: "memory"); __builtin_amdgcn_s_barrier(); asm volatile("" ::: "memory"); } while (0)
    f32x16 o[4];
#pragma unroll
    for (int i = 0; i < 4; ++i) o[i] = (f32x16){};
    float mrow, lsum = 0.f;
    LAS float* wsf = (LAS float*)(lds + 98304) + wid * 64;
    const int koff = (c * 8 + hi) * 1024 + r32 * 16;
    const int voff = ((lane >> 4) & 1) * 32 + (lane & 3) * 8 + (4 * hi + ((lane & 15) >> 2)) * 64;
    f32x16 pA0, pA1, pB0, pB1;
    LAS unsigned* redo = (LAS unsigned*)(lds + LDSCTL_OFF + 320);
    if (!TRACK) { if (tid == 0) *redo = 0u; }
    AT_DMA_K(0, 0); AT_DMA_V(0, 0); AT_DMA_K(1, 1);
    AT_WAITBAR();
    AT_DMA_K(2, 2); AT_DMA_V(1, 1);
    f32x16 negm = (f32x16){};
    att_qk_c(pA0, pA1, lds + AT_KSLOT(0) + koff, qr, negm);
    mrow = rowmax32(pA0, pA1); if (!TRACK) mrow += ATT_HEADROOM;
#pragma unroll
    for (int r = 0; r < 16; ++r) negm[r] = -mrow;
    att_qk_c(pB0, pB1, lds + AT_KSLOT(1) + koff, qr, negm);
#pragma unroll
    for (int r = 0; r < 16; ++r) { pA0[r] = __builtin_amdgcn_exp2f(pA0[r] - mrow); pA1[r] = __builtin_amdgcn_exp2f(pA1[r] - mrow); }
    int sk = 2, sv = 0;
#define AT_TOP(t) do { AT_WAITBAR(); const int sk2 = (sk == 2) ? 0 : sk + 1;   \
        if ((t) + 2 < NT) AT_DMA_K((t) + 2, sk2); if ((t) + 1 < NT) AT_DMA_V((t) + 1, sk); } while (0)
#define AT_ADV() do { sk = (sk == 2) ? 0 : sk + 1; sv = (sv == 2) ? 0 : sv + 1; } while (0)
    for (int t = 1; t + 1 < NT; t += 2) {
        AT_TOP(t);
        att_step<TRACK, true, true>(o, pA0, pA1, pB0, pB1, mrow, lsum, negm, qr, lds + AT_KSLOT(sk) + koff, lds + AT_VSLOT(sv) + voff, wsf, r32, hi);
        AT_ADV();
        AT_TOP(t + 1);
        att_step<TRACK, true, true>(o, pB0, pB1, pA0, pA1, mrow, lsum, negm, qr, lds + AT_KSLOT(sk) + koff, lds + AT_VSLOT(sv) + voff, wsf, r32, hi);
        AT_ADV();
    }
    AT_TOP(NT - 1);
    att_step<TRACK, true, false>(o, pA0, pA1, pB0, pB1, mrow, lsum, negm, qr, lds + AT_KSLOT(sk) + koff, lds + AT_VSLOT(sv) + voff, wsf, r32, hi);
    AT_ADV();
    att_step<TRACK, false, false>(o, pB0, pB1, pA0, pA1, mrow, lsum, negm, qr, lds + AT_KSLOT(sk) + koff, lds + AT_VSLOT(sv) + voff, wsf, r32, hi);
    if (!TRACK) { if (__any(!(lsum < 0x1p100f))) { if ((lane & 63) == 0) *redo = 1u; } }
    LDS_WAIT(); __builtin_amdgcn_s_barrier(); asm volatile("" ::: "memory");
    if (!TRACK) { if (__builtin_amdgcn_readfirstlane((int)*redo) != 0) { __builtin_amdgcn_s_barrier(); return false; } }
    float lt = lsum + __shfl_xor(lsum, 32);
    float inv = 1.0f / lt; if (c == 1) inv *= lam;
    if (hi == 0) wsf[r32] = inv;
    LDS_WAIT();
#pragma unroll
    for (int r = 0; r < 16; ++r) { const float ar = wsf[crow(r, hi)];
#pragma unroll
        for (int d = 0; d < 4; ++d) o[d][r] *= ar; }
    LAS float* X = (LAS float*)lds + wq * 4096;
    if (c == 1) {
#pragma unroll
        for (int d = 0; d < 4; ++d)
#pragma unroll
            for (int r = 0; r < 16; ++r) X[(d * 16 + r) * 64 + lane] = o[d][r];
    }
    LDS_WAIT(); __builtin_amdgcn_s_barrier(); asm volatile("" ::: "memory");
    if (c == 0) {
        float gs[4];
#pragma unroll
        for (int d = 0; d < 4; ++d) gs[d] = g_subln[32 * d + r32] * (1.0f - LAMBDA_INIT);
        LAS bf16_t* stg = (LAS bf16_t*)(lds + 65536 + wq * 8192);
#pragma unroll
        for (int r = 0; r < 16; ++r) {
            float ss = 0.f;
#pragma unroll
            for (int d = 0; d < 4; ++d) { o[d][r] -= X[(d * 16 + r) * 64 + lane]; ss += o[d][r] * o[d][r]; }
            ss += __shfl_xor(ss, 1); ss += __shfl_xor(ss, 2); ss += __shfl_xor(ss, 4); ss += __shfl_xor(ss, 8); ss += __shfl_xor(ss, 16);
            const float rn = __builtin_amdgcn_rsqf(ss * (1.0f / 128.0f) + EPS);
#pragma unroll
            for (int d = 0; d < 4; ++d) stg[crow(r, hi) * 128 + 32 * d + r32] = (bf16_t)f2bf(o[d][r] * rn * gs[d]);
        }
        LDS_WAIT();
        bf16_t* ob = MIX + (rowbase + qb * 128 + wq * 32) * DM + h * 128;
#pragma unroll
        for (int i = 0; i < 8; ++i) { const int row = i * 4 + (lane >> 4), ch = lane & 15; *(u32x4*)(ob + (size_t)row * DM + ch * 8) = *(const LAS u32x4*)(stg + row * 128 + ch * 8); }
    }
    LDS_WAIT(); __builtin_amdgcn_s_barrier(); asm volatile("" ::: "memory");
#undef AT_DMA_K
#undef AT_DMA_V
#undef AT_TOP
#undef AT_ADV
#undef AT_WAITBAR
    return true;
}

__device__ __forceinline__ void gmlp_unit(int ck, int hh, const bf16_t* Ug, const bf16_t* Gg, const float* lnstat, const float* ln_g, const float* ln_b, const float* w_sp, const float* b_sp, bf16_t* MIX, LAS unsigned char* lds) {
    const int tid = threadIdx.x, lane = tid & 63; const int wid = __builtin_amdgcn_readfirstlane(tid >> 6);
    constexpr int LDW = 136;
    LAS bf16_t* Ws = (LAS bf16_t*)lds;
    LAS bf16_t* VT = (LAS bf16_t*)(lds + 128 * LDW * 2);
    const size_t row0 = (size_t)ck * 128;
    { const float* wp = w_sp + (size_t)hh * 128 * 128;
#pragma unroll
      for (int i = 0; i < 8; ++i) { const int e = (tid + 512 * i) * 4, pr = e >> 7, qc = e & 127; const f32x4 v = *(const f32x4*)(wp + e);
          u32x2 w; w.x = pk2(v[0], v[1]); w.y = pk2(v[2], v[3]); *(LAS u32x2*)(Ws + pr * LDW + qc) = w; } }
    { const int q = tid & 127, dg = tid >> 7;
      const float* st = lnstat + (row0 + q) * 32; float s = 0.f, sq = 0.f;
#pragma unroll
      for (int i = 0; i < 8; ++i) { const f32x4 t4 = *(const f32x4*)(st + 4 * i); s += t4[0] + t4[2]; sq += t4[1] + t4[3]; }
      const float mean = s * (1.0f / 1024.0f), var = fmaxf(sq * (1.0f / 1024.0f) - mean * mean, 0.f), rstd = 1.0f / sqrtf(var + EPS);
      const bf16_t* gp = Gg + (row0 + q) * PARTW + hh * 128 + dg * 32;
      const float* lg = ln_g + hh * 128 + dg * 32; const float* lb = ln_b + hh * 128 + dg * 32;
#pragma unroll
      for (int i = 0; i < 4; ++i) { const bf16x8 gv = *(const bf16x8*)(gp + 8 * i);
          const f32x4 g0 = *(const f32x4*)(lg + 8 * i), g1 = *(const f32x4*)(lg + 8 * i + 4), b0 = *(const f32x4*)(lb + 8 * i), b1 = *(const f32x4*)(lb + 8 * i + 4);
#pragma unroll
          for (int j = 0; j < 8; ++j) { const int d = dg * 32 + 8 * i + j; const float gg = j < 4 ? g0[j & 3] : g1[j & 3], bbv = j < 4 ? b0[j & 3] : b1[j & 3];
              const float vn = (bf2f((unsigned short)gv[j]) - mean) * rstd * gg + bbv;
              VT[d * LDW + q] = (bf16_t)f2bf(vn); } } }
    LDS_WAIT(); __builtin_amdgcn_s_barrier(); asm volatile("" ::: "memory");
    f32x4 acc[8];
#pragma unroll
    for (int n = 0; n < 8; ++n) acc[n] = (f32x4){0.f, 0.f, 0.f, 0.f};
    const int fr = lane & 15, fq = lane >> 4;
#pragma unroll
    for (int ks = 0; ks < 4; ++ks) {
        const bf16x8 a = *(const LAS bf16x8*)(Ws + (16 * wid + fr) * LDW + 32 * ks + 8 * fq);
#pragma unroll
        for (int n = 0; n < 8; ++n) { const bf16x8 bb = *(const LAS bf16x8*)(VT + (16 * n + fr) * LDW + 32 * ks + 8 * fq);
            acc[n] = __builtin_amdgcn_mfma_f32_16x16x32_bf16(bb, a, acc[n], 0, 0, 0); }
    }
    { const int pr = 16 * wid + fr; const float bs = b_sp[hh * 128 + pr];
      const bf16_t* up = Ug + (row0 + pr) * PARTW + hh * 128 + 4 * fq; bf16_t* op = MIX + (row0 + pr) * DM + 1024 + hh * 128 + 4 * fq;
      u32x2 uv[8];
#pragma unroll
      for (int n = 0; n < 8; ++n) uv[n] = *(const u32x2*)(up + 16 * n);
#pragma unroll
      for (int n = 0; n < 8; ++n) { u32x2 w;
          w.x = pk2(__builtin_bit_cast(float, uv[n].x << 16) * (acc[n][0] + bs), __builtin_bit_cast(float, uv[n].x & 0xffff0000u) * (acc[n][1] + bs));
          w.y = pk2(__builtin_bit_cast(float, uv[n].y << 16) * (acc[n][2] + bs), __builtin_bit_cast(float, uv[n].y & 0xffff0000u) * (acc[n][3] + bs));
          *(u32x2*)(op + 16 * n) = w; } }
    LDS_WAIT(); __builtin_amdgcn_s_barrier(); asm volatile("" ::: "memory");
}

struct Args { const void* in[24]; float* out; unsigned char* ws; int ph_lo, ph_hi; };
constexpr int N_PHASES = 8;
__global__ void __launch_bounds__(512, 2) mk_fwd(Args args) {
    extern __shared__ __attribute__((aligned(16))) unsigned char lds_raw[];
    Frame F;
    F.lds = (LAS unsigned char*)lds_raw;
    F.tid = threadIdx.x; F.lane = F.tid & 63; F.wave = __builtin_amdgcn_readfirstlane(F.tid >> 6);
    F.G = gridDim.x; { const int bx = blockIdx.x; F.vcu = (F.G % 8 == 0) ? (bx % 8) * (F.G / 8) + bx / 8 : bx; }
    F.x = (const float*)args.in[0]; F.p = (const float*)args.in[1]; F.pos = (const int*)args.in[2]; F.g_mix = (const float*)args.in[3]; F.w_in = (const float*)args.in[4];
    F.lq1 = (const float*)args.in[5]; F.lk1 = (const float*)args.in[6]; F.lq2 = (const float*)args.in[7]; F.lk2 = (const float*)args.in[8]; F.g_subln = (const float*)args.in[9];
    F.ln_g = (const float*)args.in[10]; F.ln_b = (const float*)args.in[11]; F.w_sp = (const float*)args.in[12]; F.b_sp = (const float*)args.in[13]; F.w_out = (const float*)args.in[14];
    F.g_ffn = (const float*)args.in[15]; F.w_up = (const float*)args.in[16]; F.conv_w = (const float*)args.in[17]; F.conv_b = (const float*)args.in[18]; F.w_down = (const float*)args.in[19];
    F.g_ple = (const float*)args.in[20]; F.w_gate = (const float*)args.in[21]; F.w_pup = (const float*)args.in[22]; F.g_final = (const float*)args.in[23];
    F.out = args.out; F.ws = args.ws;
    unsigned char* ws = args.ws;
    for (int u = F.tid; u < 512 / 4; u += 512) ((LAS unsigned*)(F.lds + LDSCTL_OFF))[u] = 0u;
    __syncthreads();
    const int lo = args.ph_lo, hi = args.ph_hi;
    XcdBarrier bar; bar.bar = (unsigned*)(ws + WS_CTL) + CW_BAR; bar.x = 0; bar.st = nullptr;
    if (hi - lo > 1) bar = xcd_barrier_post((unsigned*)(ws + WS_CTL) + CW_BAR, (volatile LAS unsigned*)(F.lds + LDSCTL_OFF) + 8);
#ifndef PH_MASK
#define PH_MASK 0x1ff
#endif
#define IN(k) (((PH_MASK >> (k)) & 1) && lo <= (k) && (k) < hi)
#define SEAM(k) do { if (IN(k) && IN((k) + 1)) xcd_barrier(bar); } while (0)

    bf16_t* A = (bf16_t*)(ws + WS_A); bf16_t* HB1 = (bf16_t*)(ws + WS_A); bf16_t* HB2 = (bf16_t*)(ws + WS_H); float* SSQ = (float*)(ws + WS_SSQ);
    bf16_t* QKVUG = (bf16_t*)(ws + WS_QKVUG); bf16_t* MIX = (bf16_t*)(ws + WS_MIX); bf16_t* ACT = (bf16_t*)(ws + WS_ACT);
    float* HALO = (float*)(ws + WS_HALO);

    if (IN(0)) { p0_prologue(F); }
    SEAM(0);
    if (IN(1)) {
        { pg8::Gemm g{A, (const bf16_t*)(ws + WS_WINT), MTOK, NIN, DM}; pg8::StaticOrder S; S.init(MTOK, NIN, F.G, (int)blockIdx.x);
          pg8::EpiIn E{QKVUG, (const float*)(ws + WS_ROPE), (float*)(ws + WS_LNST)};
          pg8::gemm_phase<pg8::EpiIn, pg8::StaticOrder, true, true>(F.lds, g, S, E); }
        if (F.G == 256) {
            if (blockIdx.x < 128) { if (F.tid == 0) (void)q_add((unsigned*)(ws + WS_CTL) + CW_DONE1, 1u); } else conv_drain(F, 0, 128u);
        }
    }
    SEAM(1);
    if (IN(2)) {
        const float s1 = wave_sum(F.lq1[F.lane] * F.lk1[F.lane]), s2 = wave_sum(F.lq2[F.lane] * F.lk2[F.lane]);
        const float lam = expf(s1) - expf(s2) + LAMBDA_INIT;
        for (int u = F.vcu; u < NBATCH * NHEAD * 16; u += F.G) { const int bh = u >> 4, qb = u & 15;
            if (!attn_unit<ATT_FAST_TRACK>(bh >> 3, bh & 7, qb, QKVUG, QKVUG + PART_ELEMS, QKVUG + 2 * PART_ELEMS, MIX, F.g_subln, lam, F.lds))
                (void)attn_unit<true>(bh >> 3, bh & 7, qb, QKVUG, QKVUG + PART_ELEMS, QKVUG + 2 * PART_ELEMS, MIX, F.g_subln, lam, F.lds); }
        for (int u = F.vcu; u < 64 * 8; u += F.G) { const int ck = u >> 3, hh = u & 7;
            gmlp_unit(ck, hh, QKVUG + 3 * PART_ELEMS, QKVUG + 4 * PART_ELEMS, (const float*)(ws + WS_LNST), F.ln_g, F.ln_b, F.w_sp, F.b_sp, MIX, F.lds); }
        conv_drain(F, 0, 0u);
    }
    SEAM(2);
    if (IN(3)) {
        pg8::Gemm g{MIX, (const bf16_t*)(ws + WS_WOUTT), MTOK, DM, DM}; pg8::StaticOrder S; S.init(MTOK, DM, F.G, (int)blockIdx.x);
        pg8::EpiResid<2> E{HB1, HB1, SSQ, SSQ + 3 * MTOK, F.g_mix};
        pg8::gemm_phase<pg8::EpiResid<2>, pg8::StaticOrder, true, true>(F.lds, g, S, E);
    }
    SEAM(3);
    if (IN(4)) {
        pg8::Gemm g{HB1, (const bf16_t*)(ws + WS_WUPT), MTOK, NUP, DM}; pg8::StaticOrder S; S.init(MTOK, NUP, F.G, (int)blockIdx.x);
        pg8::EpiConvGlu E{ACT, HALO, SSQ, F.conv_w, F.conv_b, F.lds + XLDS_OFF};
        pg8::gemm_phase<pg8::EpiConvGlu, pg8::StaticOrder, true, true>(F.lds, g, S, E);
        {
            const bool split = (F.G == 256), is_long = split && blockIdx.x < 128;
            pg8::SmallOrder S2;
            if (split) { S2.first = 2 * ((int)blockIdx.x - 128); S2.stride = 1; S2.count = is_long ? 0 : 2; }
            else { S2.first = (int)blockIdx.x; S2.stride = F.G; S2.count = ((int)blockIdx.x < 256) ? (256 - (int)blockIdx.x + F.G - 1) / F.G : 0; }
            int zero = 0; asm volatile("" : "+s"(zero));
            S2.first += zero;
            pg8::Gemm g2{(const bf16_t*)(ws + WS_PB), (const bf16_t*)(ws + WS_WPUT), MTOK, DM, PLE};
            pg8::EpiBf16 E2{(bf16_t*)(ws + WS_UPB), DM};
            pg8::gemm_phase<pg8::EpiBf16, pg8::SmallOrder, false, true>(F.lds, g2, S2, E2, zero);
            if (split) { if (is_long) { if (F.tid == 0) (void)q_add((unsigned*)(ws + WS_CTL) + CW_DONE4, 1u); } else conv_drain(F, 1, 128u); }
        }
    }
    SEAM(4);
    if (IN(5)) {
        const int gt = F.vcu * 512 + F.tid, NGT = F.G * 512;
        constexpr int NB = MTOK / 256 - 1;
        for (int i = gt; i < NB * 2 * DFF; i += NGT) {
            const int ch = i % DFF, w = (i / DFF) & 1, bnd = i / (2 * DFF) + 1;
            if ((bnd & 7) == 0) continue;
            const int pn = ch >> 7, cc = ch & 127; const size_t gi = (size_t)pn * 256 + cc, ui = gi + 128;
            const float* hA = HALO + (size_t)(bnd - 1) * 4 * NUP; const float* hB = HALO + (size_t)bnd * 4 * NUP;
            const float* rp = (w == 0) ? hA + 2 * NUP : hA + 3 * NUP;
            const float* rc = (w == 0) ? hA + 3 * NUP : hB;
            const float* rn = (w == 0) ? hB : hB + NUP;
            const float gq = F.conv_w[ch] * rp[gi] + F.conv_w[NUP + ch] * rc[gi] + F.conv_w[2 * NUP + ch] * rn[gi] + F.conv_b[ch];
            const float uq = F.conv_w[DFF + ch] * rp[ui] + F.conv_w[NUP + DFF + ch] * rc[ui] + F.conv_w[2 * NUP + DFF + ch] * rn[ui] + F.conv_b[DFF + ch];
            const size_t row = (size_t)bnd * 256 - 1 + w;
            ACT[row * DFF + ch] = (bf16_t)f2bf(gq * __builtin_amdgcn_rcpf(1.0f + __builtin_amdgcn_exp2f(gq * (-LOG2E))) * uq);
        }
        conv_drain(F, 1, 0u);
    }
    SEAM(5);
    if (IN(6)) {
        pg8::Gemm g{ACT, (const bf16_t*)(ws + WS_WDT), MTOK, DM, DFF}; pg8::StaticOrder S; S.init(MTOK, DM, F.G, (int)blockIdx.x);
        pg8::EpiResid<1> E{HB1, HB2, SSQ + MTOK, nullptr, nullptr};
        pg8::gemm_phase<pg8::EpiResid<1>, pg8::StaticOrder, true, true>(F.lds, g, S, E);
    }
    SEAM(6);
    if (IN(7)) {
        bf16_t* UPB = (bf16_t*)(ws + WS_UPB);
        int zero = 0; asm volatile("" : "+s"(zero));
        pg8::Gemm g{HB2, (const bf16_t*)(ws + WS_WGT), MTOK, DM, DM}; pg8::StaticOrder S; S.init(MTOK, DM, F.G, (int)blockIdx.x + zero);
        pg8::EpiPle<true> E{HB2, UPB, F.out, SSQ + MTOK, SSQ + 2 * MTOK, (unsigned*)(ws + WS_CTL) + CW_PANEL, F.g_final};
        pg8::gemm_phase<pg8::EpiPle<true>, pg8::StaticOrder, true, true>(F.lds, g, S, E, zero);
    }
#undef IN
#undef SEAM
}

extern "C" void kernel_launch(void* const* d_in, const int* in_sizes, int n_in, void* d_out, int out_size, void* d_ws, size_t ws_size, hipStream_t stream) {
    static int grid = 0;
    if (grid == 0) {
        if (n_in != 24 || in_sizes[0] != MTOK * DM || out_size != MTOK * DM || ws_size < WS_END) {
            fprintf(stderr, "kernel_launch: unexpected shapes: n_in %d in0 %d out %d ws %zu (need %zu)\n", n_in, n_in > 0 ? in_sizes[0] : -1, out_size, ws_size, (size_t)WS_END); grid = -1; return; }
        int dev = 0, cus = 0, per_cu = 0;
        if (hipGetDevice(&dev) != hipSuccess || hipDeviceGetAttribute(&cus, hipDeviceAttributeMultiprocessorCount, dev) != hipSuccess) { grid = -1; return; }
        if (hipFuncSetAttribute((const void*)mk_fwd, hipFuncAttributeMaxDynamicSharedMemorySize, LDS_BYTES) != hipSuccess) { fprintf(stderr, "kernel_launch: hipFuncSetAttribute failed\n"); grid = -1; return; }
        if (hipOccupancyMaxActiveBlocksPerMultiprocessor(&per_cu, (const void*)mk_fwd, 512, LDS_BYTES) != hipSuccess || per_cu < 1) { fprintf(stderr, "kernel_launch: occupancy query says %d blocks/CU\n", per_cu); per_cu = 1; }
        (void)hipGetLastError();
        if (cus != 256) fprintf(stderr, "kernel_launch: built for a 256-CU device (one 256 x 256 unit per workgroup in the fused final-norm phase); this device has %d CUs: the output will be wrong\n", cus);
        grid = cus;
    }
    if (grid < 0) return;
    (void)hipMemsetAsync((char*)d_ws + WS_CTL, 0, CTL_ZERO_BYTES, stream);
    Args a{};
    for (int i = 0; i < 24; ++i) a.in[i] = d_in[i];
    a.out = (float*)d_out; a.ws = (unsigned char*)d_ws;
#if MK_N_LAUNCHES == 1
    a.ph_lo = 0; a.ph_hi = N_PHASES;
    hipLaunchKernelGGL(mk_fwd, dim3(grid), dim3(512), LDS_BYTES, stream, a);
#else
    for (int li = 0; li < N_PHASES; ++li) { a.ph_lo = li; a.ph_hi = li + 1; hipLaunchKernelGGL(mk_fwd, dim3(grid), dim3(512), LDS_BYTES, stream, a); }
#endif
}
```

```cpp
#include <hip/hip_runtime.h>
#include <cstdio>
#include <cstdint>

#ifndef MK_N_LAUNCHES
#define MK_N_LAUNCHES 1
#endif

#define LAS __attribute__((address_space(3)))
#define GAS __attribute__((address_space(1)))
typedef unsigned short bf16_t;
typedef short bf16x8 __attribute__((ext_vector_type(8)));
typedef short s16x4 __attribute__((ext_vector_type(4)));
typedef float f32x4 __attribute__((ext_vector_type(4)));
typedef float f32x2 __attribute__((ext_vector_type(2)));
typedef float f32x16 __attribute__((ext_vector_type(16)));
typedef unsigned u32x4 __attribute__((ext_vector_type(4)));
typedef unsigned u32x2 __attribute__((ext_vector_type(2)));
typedef __bf16 bf16x2_t __attribute__((ext_vector_type(2)));

constexpr int DM = 2048, NBATCH = 4, SEQ = 2048, MTOK = NBATCH * SEQ;
constexpr int NIN = 5120, PARTW = 1024, DFF = 5632, NUP = 2 * DFF, PLE = 256, NHEAD = 8;
constexpr float EPS = 1e-6f;
constexpr float LOG2E = 1.4426950408889634f;
constexpr float C2 = 0.125f * LOG2E;
constexpr float LAMBDA_INIT = 0.2f;

constexpr size_t MiB = 1u << 20;
constexpr size_t WS_CTL = 0, CTL_ZERO_BYTES = 64 * 1024;
constexpr size_t WS_ROPE = 1 * MiB;
constexpr size_t WS_LNST = 2 * MiB;
constexpr size_t WS_SSQ  = 3 * MiB;
constexpr size_t WS_WPUT = 4 * MiB;
constexpr size_t WS_PB   = 5 * MiB;
constexpr size_t WS_HALO = 9 * MiB;
constexpr size_t WS_WINT = 16 * MiB;
constexpr size_t WS_WOUTT = 36 * MiB;
constexpr size_t WS_WUPT = 44 * MiB;
constexpr size_t WS_WDT  = 88 * MiB;
constexpr size_t WS_WGT  = 110 * MiB;
constexpr size_t WS_A    = 118 * MiB;
constexpr size_t WS_H    = 150 * MiB;
constexpr size_t WS_UPB  = 182 * MiB;
constexpr size_t WS_QKVUG = 214 * MiB;
constexpr size_t PART_ELEMS = (size_t)MTOK * PARTW;
constexpr size_t WS_MIX  = 294 * MiB;
constexpr size_t WS_ACT  = 214 * MiB;
constexpr size_t WS_END  = 326 * MiB;
static_assert(WS_ACT + (size_t)MTOK * DFF * 2 <= WS_END && WS_MIX + (size_t)MTOK * DM * 2 <= WS_END, "ws map");

constexpr int CW_BAR = 1024;
constexpr int CW_PANEL = 8192;
constexpr int CW_QA = 4608, CW_QB = 5120, CW_DONE1 = 192, CW_DONE4 = 256;

constexpr int RING_BYTES = 131072;
constexpr int XLDS_OFF = RING_BYTES;
constexpr int LDS_BYTES = 147456;
constexpr int LDSCTL_OFF = LDS_BYTES - 512;
constexpr int CONV_LDS_PER_WAVE = 64 * 65 * 4;
static_assert(XLDS_OFF + 8192 <= LDSCTL_OFF && 8 * CONV_LDS_PER_WAVE <= LDSCTL_OFF, "lds map");

__device__ __forceinline__ unsigned f2bf(float f) { unsigned u = __builtin_bit_cast(unsigned, f); return (u + 0x7fffu + ((u >> 16) & 1u)) >> 16; }
__device__ __forceinline__ unsigned pk2(float lo, float hi) { f32x2 v = {lo, hi}; bf16x2_t b = __builtin_convertvector(v, bf16x2_t); return __builtin_bit_cast(unsigned, b); }
__device__ __forceinline__ float bf2f(unsigned short b) { return __builtin_bit_cast(float, (unsigned)b << 16); }
__device__ __forceinline__ float wave_sum(float v) {
#pragma unroll
    for (int o = 1; o < 64; o <<= 1) v += __shfl_xor(v, o);
    return v;
}
#define LDS_WAIT() asm volatile("s_waitcnt lgkmcnt(0)" ::: "memory")
#define VM_WAIT() asm volatile("s_waitcnt vmcnt(0)" ::: "memory")

__device__ __forceinline__ int fresh_lane() { int l; asm volatile("v_mbcnt_lo_u32_b32 %0, -1, 0\n\tv_mbcnt_hi_u32_b32 %0, -1, %0" : "=v"(l)); return l; }
namespace pg8 {
constexpr int BM = 256, BK = 64, HALF = 128, HTB = HALF * BK * 2, STAGE_BYTES = 8 * HTB, NXCD = 8, WGM = 8;
__host__ __device__ __forceinline__ int lds_byte(int r, int c) { const int st = (r >> 4) * 2 + (c >> 5), rr = r & 15, cc = c & 31, ob = rr * 64 + cc * 2; return st * 1024 + (ob ^ (((ob >> 9) & 1) << 5)); }
__host__ __device__ __forceinline__ void stage_rc(int b, int& R, int& C) { const int st = b / 1024, sb = b % 1024, swz = sb ^ (((sb >> 9) & 1) << 5); R = (st >> 1) * 16 + swz / 64; C = (st & 1) * 32 + (swz % 64) / 2; }
__host__ __device__ __forceinline__ int perm32(int rho) { const int n = rho >> 4, i = rho & 15; return 8 * (i >> 2) + 4 * n + (i & 3); }

struct Unit { int pm, pn; };
struct Gemm { const bf16_t* A; const bf16_t* Bt; int M, N, K; };

struct StaticOrder {
    int nM, nN, nwg, G, c;
    __host__ __device__ void init(int M, int N, int G_, int c_) { nM = M / BM; nN = N / BM; nwg = nM * nN; G = G_; c = c_; }
    __host__ __device__ bool next(int i, Unit& u) const {
        const long L = (long)i * G + c; if (L >= nwg) return false;
        int wgid = (int)L; { const int q = nwg / NXCD, r = nwg % NXCD, xcd = wgid % NXCD, off = wgid / NXCD; wgid = (xcd < r ? xcd * (q + 1) : r * (q + 1) + (xcd - r) * q) + off; }
        const int nig = WGM * nN, gid = wgid / nig, fm = gid * WGM, gsz = (nM - fm) < WGM ? (nM - fm) : WGM;
        u.pm = fm + ((wgid % nig) % gsz); u.pn = (wgid % nig) / gsz; return true;
    }
    __device__ __forceinline__ void a_ready(const Unit&) const {}
    __device__ __forceinline__ void done(const Unit&) const {}
};

struct SmallOrder {
    int first, stride, count;
    __device__ __forceinline__ bool next(int i, Unit& u) const { if (i >= count) return false; const int v = first + i * stride; u.pm = v >> 3; u.pn = v & 7; return true; }
    __device__ __forceinline__ void a_ready(const Unit&) const {}
    __device__ __forceinline__ void done(const Unit&) const {}
};

__device__ __forceinline__ f32x2 gelu_pk(f32x2 v) {
    const f32x2 av = __builtin_elementwise_abs(v), d = av * 0.2316418882f + 1.0f;
    f32x2 t; t.x = __builtin_amdgcn_rcpf(d.x); t.y = __builtin_amdgcn_rcpf(d.y);
    f32x2 q = t * 0.5307027145f + (-0.7265760135f); q = q * t + 0.7107068705f; q = q * t + (-0.142248368f); q = q * t + 0.127414796f; q = q * t;
    const f32x2 s = (v * v) * (-0.72134752044f);
    f32x2 e; e.x = __builtin_amdgcn_exp2f(s.x); e.y = __builtin_amdgcn_exp2f(s.y);
    const f32x2 m = v * (q * e), r = v - m;
    f32x2 o; o.x = v.x < 0.f ? m.x : r.x; o.y = v.y < 0.f ? m.y : r.y; return o;
}
__device__ __forceinline__ f32x4 gelu4(f32x4 v) { const f32x2 a = gelu_pk((f32x2){v[0], v[1]}), b = gelu_pk((f32x2){v[2], v[3]}); return (f32x4){a.x, a.y, b.x, b.y}; }
__device__ __forceinline__ u32x4 pack8(f32x4 v0, f32x4 v1) { u32x4 w; w.x = pk2(v0[0], v0[1]); w.y = pk2(v0[2], v0[3]); w.z = pk2(v1[0], v1[1]); w.w = pk2(v1[2], v1[3]); return w; }
__device__ __forceinline__ float dot4(f32x4 a) { return (a[0] * a[0] + a[1] * a[1]) + (a[2] * a[2] + a[3] * a[3]); }
__device__ __forceinline__ float sum4(f32x4 a) { return (a[0] + a[1]) + (a[2] + a[3]); }
__device__ __forceinline__ f32x4 shfl_xor4(f32x4 v, int m) { return (f32x4){__shfl_xor(v[0], m), __shfl_xor(v[1], m), __shfl_xor(v[2], m), __shfl_xor(v[3], m)}; }


struct EpiIn {
    static constexpr bool PERM = true, AFTER_DRAIN = false;
    bf16_t* qkvug; const float* rope; float* lnstat;
    __device__ __forceinline__ void operator()(f32x4 (&acc)[2][2][4][2], const Unit& u, int wr, int wc, int fr, int fq) const {
        const int t = u.pn >> 2, colt = (u.pn & 3) * BM;
        bf16_t* base = qkvug + (size_t)t * PART_ELEMS;
        const int row0 = u.pm * BM + wr * 64 + fr, col0 = colt + wc * 32 + 8 * fq;
        if (t <= 1) {
            const float sc = (t == 0) ? C2 : 1.0f;
            const bool rotw = ((wc & 1) == 0);
            const float sgn = (fq == 0) ? -1.0f : 1.0f;
#pragma unroll
            for (int ai = 0; ai < 2; ++ai)
#pragma unroll
                for (int m = 0; m < 4; ++m) {
                    const int row = row0 + ai * HALF + m * 16;
                    f32x4 c0 = {1.f, 1.f, 1.f, 1.f}, c1 = c0, s0 = {0.f, 0.f, 0.f, 0.f}, s1 = s0;
                    if (rotw) { const float* rp = rope + (size_t)row * 16; c0 = *(const f32x4*)(rp); c1 = *(const f32x4*)(rp + 4); s0 = *(const f32x4*)(rp + 8); s1 = *(const f32x4*)(rp + 12); }
#pragma unroll
                    for (int bj = 0; bj < 2; ++bj) {
                        f32x4 v0 = acc[ai][bj][m][0], v1 = acc[ai][bj][m][1];
                        if (rotw) {
                            const f32x4 p0 = shfl_xor4(v0, 16), p1 = shfl_xor4(v1, 16);
                            const f32x4 r0 = v0 * c0 + (p0 * s0) * sgn, r1 = v1 * c1 + (p1 * s1) * sgn;
                            if (fq < 2) { v0 = r0; v1 = r1; }
                        }
                        v0 = v0 * sc; v1 = v1 * sc;
                        *(u32x4*)(base + (size_t)row * PARTW + col0 + bj * HALF) = pack8(v0, v1);
                    }
                }
        } else if (t == 2) {
#pragma unroll
            for (int ai = 0; ai < 2; ++ai)
#pragma unroll
                for (int m = 0; m < 4; ++m) {
                    const int row = row0 + ai * HALF + m * 16;
#pragma unroll
                    for (int bj = 0; bj < 2; ++bj) *(u32x4*)(base + (size_t)row * PARTW + col0 + bj * HALF) = pack8(acc[ai][bj][m][0], acc[ai][bj][m][1]);
                }
        } else {
#pragma unroll
            for (int ai = 0; ai < 2; ++ai)
#pragma unroll
                for (int m = 0; m < 4; ++m) {
                    const int row = row0 + ai * HALF + m * 16;
                    float s = 0.f, q = 0.f;
#pragma unroll
                    for (int bj = 0; bj < 2; ++bj) {
                        const f32x4 v0 = gelu4(acc[ai][bj][m][0]), v1 = gelu4(acc[ai][bj][m][1]);
                        s += sum4(v0) + sum4(v1); q += dot4(v0) + dot4(v1);
                        *(u32x4*)(base + (size_t)row * PARTW + col0 + bj * HALF) = pack8(v0, v1);
                    }
                    if (t == 4) {
                        s += __shfl_xor(s, 16); s += __shfl_xor(s, 32); q += __shfl_xor(q, 16); q += __shfl_xor(q, 32);
                        if (fq == 0) *(f32x2*)(lnstat + ((size_t)row * 16 + (u.pn & 3) * 4 + wc) * 2) = (f32x2){s, q};
                    }
                }
        }
    }
};

struct EpiBf16 {
    static constexpr bool PERM = true, AFTER_DRAIN = false;
    bf16_t* C; int ldc;
    __device__ __forceinline__ void operator()(f32x4 (&acc)[2][2][4][2], const Unit& u, int wr, int wc, int fr, int fq) const {
        const int row0 = u.pm * BM + wr * 64 + fr, col0 = u.pn * BM + wc * 32 + 8 * fq;
#pragma unroll
        for (int ai = 0; ai < 2; ++ai)
#pragma unroll
            for (int m = 0; m < 4; ++m) { bf16_t* rowp = C + (size_t)(row0 + ai * HALF + m * 16) * ldc + col0;
#pragma unroll
                for (int bj = 0; bj < 2; ++bj) *(u32x4*)(rowp + bj * HALF) = pack8(acc[ai][bj][m][0], acc[ai][bj][m][1]); }
    }
};
struct EpiF32 {
    static constexpr bool PERM = true, AFTER_DRAIN = false;
    float* C; int ldc;
    __device__ __forceinline__ void operator()(f32x4 (&acc)[2][2][4][2], const Unit& u, int wr, int wc, int fr, int fq) const {
        const int row0 = u.pm * BM + wr * 64 + fr, col0 = u.pn * BM + wc * 32 + 8 * fq;
#pragma unroll
        for (int ai = 0; ai < 2; ++ai)
#pragma unroll
            for (int m = 0; m < 4; ++m) { float* rowp = C + (size_t)(row0 + ai * HALF + m * 16) * ldc + col0;
#pragma unroll
                for (int bj = 0; bj < 2; ++bj) { *(f32x4*)(rowp + bj * HALF) = acc[ai][bj][m][0]; *(f32x4*)(rowp + bj * HALF + 4) = acc[ai][bj][m][1]; } }
    }
};

__device__ __forceinline__ void unpack8(u32x4 w, f32x4& a, f32x4& b) {
    a = (f32x4){__builtin_bit_cast(float, w.x << 16), __builtin_bit_cast(float, w.x & 0xffff0000u), __builtin_bit_cast(float, w.y << 16), __builtin_bit_cast(float, w.y & 0xffff0000u)};
    b = (f32x4){__builtin_bit_cast(float, w.z << 16), __builtin_bit_cast(float, w.z & 0xffff0000u), __builtin_bit_cast(float, w.w << 16), __builtin_bit_cast(float, w.w & 0xffff0000u)};
}
template <int MODE>
struct EpiResid {
    static constexpr bool PERM = true, AFTER_DRAIN = false;
    const void* base; bf16_t* out; float* ssq; const float* sd0; const float* gmix;
    __device__ __forceinline__ void operator()(f32x4 (&acc)[2][2][4][2], const Unit& u, int wr, int wc, int fr, int fq) const {
        const int row0 = u.pm * BM + wr * 64 + fr, col0 = u.pn * BM + wc * 32 + 8 * fq;
        f32x4 gi[2][2];
        if (MODE == 2) {
#pragma unroll
            for (int bj = 0; bj < 2; ++bj)
#pragma unroll
                for (int n = 0; n < 2; ++n) { const f32x4 gq = *(const f32x4*)(gmix + col0 + bj * HALF + 4 * n);
#pragma unroll
                    for (int j = 0; j < 4; ++j) gi[bj][n][j] = (gq[j] != 0.f) ? __builtin_amdgcn_rcpf(gq[j]) : 0.f; }
        }
#pragma unroll
        for (int ai = 0; ai < 2; ++ai)
#pragma unroll
            for (int m = 0; m < 4; ++m) {
                const int row = row0 + ai * HALF + m * 16; float ss = 0.f;
                float sd = 1.f; if (MODE == 2) sd = sd0[row];
#pragma unroll
                for (int bj = 0; bj < 2; ++bj) {
                    const size_t off = (size_t)row * DM + col0 + bj * HALF;
                    f32x4 b0, b1;
                    if (MODE == 0) { b0 = *(const f32x4*)((const float*)base + off); b1 = *(const f32x4*)((const float*)base + off + 4); }
                    else { unpack8(*(const u32x4*)((const bf16_t*)base + off), b0, b1); if (MODE == 2) { b0 = b0 * sd * gi[bj][0]; b1 = b1 * sd * gi[bj][1]; } }
                    const f32x4 h0 = b0 + acc[ai][bj][m][0], h1 = b1 + acc[ai][bj][m][1];
                    ss += dot4(h0) + dot4(h1);
                    *(u32x4*)(out + off) = pack8(h0, h1);
                }
                ss += __shfl_xor(ss, 16); ss += __shfl_xor(ss, 32);
                if (fq == 0) unsafeAtomicAdd(ssq + row, ss);
            }
    }
};

template <bool FUSED>
struct EpiPle {
    static constexpr bool PERM = true, AFTER_DRAIN = false;
    const bf16_t* h; const bf16_t* upb; float* out; const float* ssq_in; float* ssq; unsigned* cnt; const float* gfin;
    __device__ __forceinline__ void operator()(f32x4 (&acc)[2][2][4][2], const Unit& u, int wr, int wc, int fr, int fq) const {
        const int row0 = u.pm * BM + wr * 64 + fr, col0 = u.pn * BM + wc * 32 + 8 * fq;
        constexpr int PD = 3;
        u32x4 hr[8][2], ur[8][2]; float sq[8];
#define PLE_LOAD(g) do { const int row_ = row0 + ((g) >> 2) * HALF + ((g) & 3) * 16; sq[g] = ssq_in[row_]; \
            _Pragma("unroll") for (int bj = 0; bj < 2; ++bj) { const unsigned ob_ = (unsigned)((row_ * DM + col0 + bj * HALF) * 2); \
                hr[g][bj] = *(const u32x4*)((const char*)h + ob_); ur[g][bj] = *(const u32x4*)((const char*)upb + ob_); } } while (0)
#pragma unroll
        for (int g = 0; g < PD; ++g) PLE_LOAD(g);
#pragma unroll
        for (int g = 0; g < 8; ++g) {
            const int ai = g >> 2, m = g & 3;
            const int row = row0 + ai * HALF + m * 16; float ss = 0.f;
            if (g + PD < 8) PLE_LOAD((g + PD) & 7);
            const float rs = __builtin_amdgcn_rsqf(sq[g] * (1.0f / DM) + EPS) * (-LOG2E);
#pragma unroll
            for (int bj = 0; bj < 2; ++bj) {
                const size_t off = (size_t)row * DM + col0 + bj * HALF;
                f32x4 hb[2], ub[2]; unpack8(hr[g][bj], hb[0], hb[1]); unpack8(ur[g][bj], ub[0], ub[1]);
#pragma unroll
                for (int n = 0; n < 2; ++n) {
                    const f32x4 z = acc[ai][bj][m][n] * rs;
                    f32x4 gt;
#pragma unroll
                    for (int j = 0; j < 4; ++j) gt[j] = __builtin_amdgcn_rcpf(1.0f + __builtin_amdgcn_exp2f(z[j]));
                    const f32x4 h3 = hb[n] + ub[n] * gt;
                    if (FUSED) acc[ai][bj][m][n] = h3; else *(f32x4*)(out + off + 4 * n) = h3;
                    ss += dot4(h3);
                }
            }
            ss += __shfl_xor(ss, 16); ss += __shfl_xor(ss, 32);
            if (fq == 0) unsafeAtomicAdd(ssq + row, ss);
        }
#undef PLE_LOAD
        if (FUSED) {
            f32x4 gf[2][2];
#pragma unroll
            for (int bj = 0; bj < 2; ++bj)
#pragma unroll
                for (int n = 0; n < 2; ++n) gf[bj][n] = *(const f32x4*)(gfin + col0 + bj * HALF + 4 * n);
            asm volatile("s_waitcnt vmcnt(0)" ::: "memory");
            unsigned* pc = cnt + 64 * u.pm;
            if ((threadIdx.x & 63) == 0) (void)__hip_atomic_fetch_add(pc, 1u, __ATOMIC_RELAXED, __HIP_MEMORY_SCOPE_AGENT);
            { unsigned sp = 0;
              while ((unsigned)__builtin_amdgcn_readfirstlane((int)__hip_atomic_load(pc, __ATOMIC_RELAXED, __HIP_MEMORY_SCOPE_AGENT)) < 64u) { __builtin_amdgcn_s_sleep(2); if (++sp > (1u << 20)) break; } }
            float tot[8];
#pragma unroll
            for (int g = 0; g < 8; ++g) { tot[g] = 0.f; if (fq == 0) tot[g] = unsafeAtomicAdd(ssq + row0 + (g >> 2) * HALF + (g & 3) * 16, 0.0f); }
#pragma unroll
            for (int g = 0; g < 8; ++g) {
                const int ai = g >> 2, m = g & 3;
                const int row = row0 + ai * HALF + m * 16;
                const float t = __shfl(tot[g], fr);
                const float rn = __builtin_amdgcn_rsqf(t * (1.0f / DM) + EPS);
#pragma unroll
                for (int bj = 0; bj < 2; ++bj)
#pragma unroll
                    for (int n = 0; n < 2; ++n) *(f32x4*)(out + (size_t)row * DM + col0 + bj * HALF + 4 * n) = acc[ai][bj][m][n] * rn * gf[bj][n];
            }
        }
    }
};

__device__ __forceinline__ float dpp_ror1(float v) { float r; asm volatile("s_nop 1\n\tv_mov_b32_dpp %0, %1 row_ror:1 row_mask:0xf bank_mask:0xf" : "=v"(r) : "v"(v)); return r; }
__device__ __forceinline__ float dpp_rol1(float v) { float r; asm volatile("s_nop 1\n\tv_mov_b32_dpp %0, %1 row_ror:15 row_mask:0xf bank_mask:0xf" : "=v"(r) : "v"(v)); return r; }
__device__ __forceinline__ f32x4 ror4(f32x4 v) { return (f32x4){dpp_ror1(v[0]), dpp_ror1(v[1]), dpp_ror1(v[2]), dpp_ror1(v[3])}; }
__device__ __forceinline__ f32x4 rol4(f32x4 v) { return (f32x4){dpp_rol1(v[0]), dpp_rol1(v[1]), dpp_rol1(v[2]), dpp_rol1(v[3])}; }
__device__ __forceinline__ void dpp_rot8(f32x4& pv, f32x4& nx, const f32x4& sp, const f32x4& sn) {
    float p0, p1, p2, p3, n0, n1, n2, n3;
    asm volatile("s_nop 1\n\t"
                 "v_mov_b32_dpp %0, %8 row_ror:1 row_mask:0xf bank_mask:0xf\n\t"
                 "v_mov_b32_dpp %1, %9 row_ror:1 row_mask:0xf bank_mask:0xf\n\t"
                 "v_mov_b32_dpp %2, %10 row_ror:1 row_mask:0xf bank_mask:0xf\n\t"
                 "v_mov_b32_dpp %3, %11 row_ror:1 row_mask:0xf bank_mask:0xf\n\t"
                 "v_mov_b32_dpp %4, %12 row_ror:15 row_mask:0xf bank_mask:0xf\n\t"
                 "v_mov_b32_dpp %5, %13 row_ror:15 row_mask:0xf bank_mask:0xf\n\t"
                 "v_mov_b32_dpp %6, %14 row_ror:15 row_mask:0xf bank_mask:0xf\n\t"
                 "v_mov_b32_dpp %7, %15 row_ror:15 row_mask:0xf bank_mask:0xf"
                 : "=&v"(p0), "=&v"(p1), "=&v"(p2), "=&v"(p3), "=&v"(n0), "=&v"(n1), "=&v"(n2), "=&v"(n3)
                 : "v"(sp[0]), "v"(sp[1]), "v"(sp[2]), "v"(sp[3]), "v"(sn[0]), "v"(sn[1]), "v"(sn[2]), "v"(sn[3]));
    pv = (f32x4){p0, p1, p2, p3}; nx = (f32x4){n0, n1, n2, n3};
}
__device__ __forceinline__ f32x4 fma4(f32x4 a, f32x4 b, f32x4 c) { return (f32x4){__builtin_fmaf(a[0], b[0], c[0]), __builtin_fmaf(a[1], b[1], c[1]), __builtin_fmaf(a[2], b[2], c[2]), __builtin_fmaf(a[3], b[3], c[3])}; }
struct EpiConvGlu {
    static constexpr bool PERM = true, AFTER_DRAIN = false;
    bf16_t* act; float* halo; const float* ssq_in; const float* cw; const float* cb; LAS unsigned char* xl;
    __device__ __forceinline__ void operator()(f32x4 (&acc)[2][2][4][2], const Unit& u, int wr, int wc, int fr, int fq) const {
        const int row0 = u.pm * BM + wr * 64 + fr, cc0 = wc * 32 + 8 * fq;
#pragma unroll
        for (int ai = 0; ai < 2; ++ai)
#pragma unroll
            for (int m = 0; m < 4; ++m) {
                const float rs = __builtin_amdgcn_rsqf(ssq_in[row0 + ai * HALF + m * 16] * (1.0f / DM) + EPS);
#pragma unroll
                for (int bj = 0; bj < 2; ++bj)
#pragma unroll
                    for (int n = 0; n < 2; ++n) acc[ai][bj][m][n] = acc[ai][bj][m][n] * rs;
            }
#ifndef NO_CONV2
        LAS float* XF = (LAS float*)xl;
        LAS float* XL = (LAS float*)(xl + 4096);
#pragma unroll
        for (int ai = 0; ai < 2; ++ai) {
            const int run = ai * 2 + wr;
#pragma unroll
            for (int bj = 0; bj < 2; ++bj)
#pragma unroll
                for (int n = 0; n < 2; ++n) {
                    const int col = bj * HALF + cc0 + 4 * n;
                    if (fr == 0) *(LAS f32x4*)(XF + run * 256 + col) = acc[ai][bj][0][n];
                    if (fr == 15) *(LAS f32x4*)(XL + run * 256 + col) = acc[ai][bj][3][n];
                }
        }
        {
            float* hb = halo + (size_t)u.pm * 4 * NUP + (size_t)u.pn * BM;
            if (wr == 0 && fr < 2) {
#pragma unroll
                for (int bj = 0; bj < 2; ++bj)
#pragma unroll
                    for (int n = 0; n < 2; ++n) *(f32x4*)(hb + (size_t)fr * NUP + bj * HALF + cc0 + 4 * n) = acc[0][bj][0][n];
            }
            if (wr == 1 && fr >= 14) {
#pragma unroll
                for (int bj = 0; bj < 2; ++bj)
#pragma unroll
                    for (int n = 0; n < 2; ++n) *(f32x4*)(hb + (size_t)(fr - 12) * NUP + bj * HALF + cc0 + 4 * n) = acc[1][bj][3][n];
            }
        }
        asm volatile("s_waitcnt lgkmcnt(0)" ::: "memory"); __builtin_amdgcn_s_barrier(); asm volatile("" ::: "memory");
#else
        LAS float* XF = (LAS float*)xl; LAS float* XL = (LAS float*)(xl + 4096);
#endif
#ifndef NO_CONV3
        const int chbase = u.pn * HALF + cc0;
#pragma unroll
        for (int bj = 0; bj < 2; ++bj) {
#pragma unroll
            for (int n = 0; n < 2; ++n) {
                const int ch = bj * DFF + chbase + 4 * n, col = bj * HALF + cc0 + 4 * n;
                const f32x4 w0 = *(const f32x4*)(cw + ch), w1 = *(const f32x4*)(cw + NUP + ch), w2 = *(const f32x4*)(cw + 2 * NUP + ch), bb = *(const f32x4*)(cb + ch);
#pragma unroll
                for (int ai = 0; ai < 2; ++ai) {
                    const int run = ai * 2 + wr;
                    f32x4 hp = {0.f, 0.f, 0.f, 0.f}, hn = {0.f, 0.f, 0.f, 0.f};
                    if (run > 0) hp = *(const LAS f32x4*)(XL + (run - 1) * 256 + col);
                    if (run < 3) hn = *(const LAS f32x4*)(XF + (run + 1) * 256 + col);
                    f32x4 pv[4], nx[4];
#pragma unroll
                    for (int m = 0; m < 4; ++m) {
                        const f32x4 old = acc[ai][bj][m][n];
                        const f32x4 below = (m > 0) ? acc[ai][bj][m > 0 ? m - 1 : 0][n] : hp;
                        const f32x4 above = (m < 3) ? acc[ai][bj][m < 3 ? m + 1 : 3][n] : hn;
                        dpp_rot8(pv[m], nx[m], (fr == 15) ? below : old, (fr == 0) ? above : old);
                    }
#pragma unroll
                    for (int m = 0; m < 4; ++m) acc[ai][bj][m][n] = fma4(w2, nx[m], fma4(w1, acc[ai][bj][m][n], fma4(w0, pv[m], bb)));
                    asm volatile("" : "+v"(acc[ai][bj][0][n]), "+v"(acc[ai][bj][1][n]), "+v"(acc[ai][bj][2][n]), "+v"(acc[ai][bj][3][n]));
                    __builtin_amdgcn_sched_barrier(0);
                }
            }
        }
#else
        const int chbase = u.pn * HALF + cc0;
#endif
#pragma unroll
        for (int ai = 0; ai < 2; ++ai)
#pragma unroll
            for (int m = 0; m < 4; ++m) {
                const int row = row0 + ai * HALF + m * 16;
                f32x4 o[2];
#pragma unroll
                for (int n = 0; n < 2; ++n) { const f32x4 gq = acc[ai][0][m][n], uq = acc[ai][1][m][n];
#pragma unroll
                    for (int j = 0; j < 4; ++j) o[n][j] = gq[j] * __builtin_amdgcn_rcpf(1.0f + __builtin_amdgcn_exp2f(gq[j] * (-LOG2E))) * uq[j]; }
                *(u32x4*)(act + (size_t)row * DFF + chbase) = pack8(o[0], o[1]);
            }
    }
};

template <class Epi, class Sched, bool ALIGN_EPI = false, bool SP2 = false>
__device__ __forceinline__ void gemm_phase(LAS unsigned char* lds, const Gemm g, const Sched& S, const Epi& E, int tid_bias = 0) {
    const int wid = __builtin_amdgcn_readfirstlane((int)(threadIdx.x >> 6)) + tid_bias, lane = fresh_lane(), tid = wid * 64 + lane, wr = wid >> 2, wc = wid & 3, fr = lane & 15, fq = lane >> 4;
    const int K = g.K, nt = K / BK;
    unsigned voffA[2], voffB[2];
#pragma unroll
    for (int i = 0; i < 2; ++i) { int R, C; stage_rc(tid * 16 + i * 8192, R, C); const int Rb = Epi::PERM ? ((R & ~31) + perm32(R & 31)) : R;
        voffA[i] = (unsigned)(R * K + C) * 2u; voffB[i] = (unsigned)(Rb * K + C) * 2u; }
    const size_t kstep = (size_t)(BK * 2);
    const size_t hstep = (size_t)HALF * K * 2;
    const size_t tstep = 2 * hstep;
    const unsigned ldsw = (unsigned)wid * 1024u;
    const int aoff = lds_byte(wr * 64 + fr, fq * 8), boff = lds_byte(wc * 32 + fr, fq * 8);
#define PG8_SA(b, h) (((b) * 2 + (h)) * HTB)
#define PG8_SB(b, h) ((4 + (b) * 2 + (h)) * HTB)
#define PG8_STAGE(bufoff, gbase, voff) do { _Pragma("unroll") for (int _i = 0; _i < 2; ++_i) \
        __builtin_amdgcn_global_load_lds((const unsigned*)((const char*)(gbase) + (voff)[_i]), (LAS unsigned*)(lds + (bufoff) + ldsw + _i * 8192), 16, 0, 0); } while (0)
#define PG8_LDA(dst, b, h) do { _Pragma("unroll") for (int m = 0; m < 4; ++m) _Pragma("unroll") for (int k = 0; k < 2; ++k) dst[m][k] = *(const LAS bf16x8*)(lds + PG8_SA(b, h) + aoff + m * 2048 + k * 1024); } while (0)
#define PG8_LDB(dst, b, h) do { _Pragma("unroll") for (int n = 0; n < 2; ++n) _Pragma("unroll") for (int k = 0; k < 2; ++k) dst[n][k] = *(const LAS bf16x8*)(lds + PG8_SB(b, h) + boff + n * 2048 + k * 1024); } while (0)
#define PG8_MMA(ai, bj, At, Bt) do { __builtin_amdgcn_s_setprio(1); _Pragma("unroll") for (int m = 0; m < 4; ++m) _Pragma("unroll") for (int n = 0; n < 2; ++n) _Pragma("unroll") for (int k = 0; k < 2; ++k) \
        acc[ai][bj][m][n] = __builtin_amdgcn_mfma_f32_16x16x32_bf16(Bt[n][k], At[m][k], acc[ai][bj][m][n], 0, 0, 0); __builtin_amdgcn_s_setprio(0); } while (0)
#define PG8_WAIT_V(n) asm volatile("s_waitcnt vmcnt(" #n ")" ::: "memory")
#define PG8_WAIT_L(n) asm volatile("s_waitcnt lgkmcnt(" #n ")" ::: "memory")
#define PG8_BAR __builtin_amdgcn_s_barrier()
#define PG8_SCHED __builtin_amdgcn_sched_barrier(0)
    Unit cur, nxt; int ui = 0;
    if (!S.next(0, cur)) return;
    f32x4 acc[2][2][4][2];
#pragma unroll
    for (int a = 0; a < 2; ++a)
#pragma unroll
        for (int b = 0; b < 2; ++b)
#pragma unroll
            for (int m = 0; m < 4; ++m)
#pragma unroll
                for (int n = 0; n < 2; ++n) acc[a][b][m][n] = (f32x4){0.f, 0.f, 0.f, 0.f};
    bf16x8 At[4][2], B0[2][2], B1[2][2];
    const char* cA = (const char*)g.A + (size_t)cur.pm * tstep; const char* cB = (const char*)g.Bt + (size_t)cur.pn * tstep;
    S.a_ready(cur);
    if constexpr (SP2) {
        PG8_STAGE(PG8_SB(0, 0), cB, voffB); PG8_STAGE(PG8_SB(0, 1), cB + hstep, voffB); PG8_STAGE(PG8_SA(0, 0), cA, voffA); PG8_STAGE(PG8_SA(0, 1), cA + hstep, voffA);
        if (wr == 1) PG8_BAR;
        PG8_WAIT_V(2); PG8_BAR;
        PG8_STAGE(PG8_SB(1, 0), cB + kstep, voffB); PG8_STAGE(PG8_SA(1, 0), cA + kstep, voffA); PG8_STAGE(PG8_SB(1, 1), cB + hstep + kstep, voffB);
        PG8_WAIT_V(6); PG8_BAR;
    } else {
        PG8_STAGE(PG8_SB(0, 0), cB, voffB); PG8_STAGE(PG8_SA(0, 0), cA, voffA); PG8_STAGE(PG8_SB(0, 1), cB + hstep, voffB); PG8_STAGE(PG8_SA(0, 1), cA + hstep, voffA);
        if (wr == 1) PG8_BAR;
        PG8_WAIT_V(4); PG8_BAR;
        PG8_STAGE(PG8_SB(1, 0), cB + kstep, voffB); PG8_STAGE(PG8_SA(1, 0), cA + kstep, voffA); PG8_STAGE(PG8_SB(1, 1), cB + hstep + kstep, voffB);
        PG8_WAIT_V(6); PG8_BAR;
    }
    for (;;) {
        const bool has_next = S.next(ui + 1, nxt);
        const char* nA = has_next ? (const char*)g.A + (size_t)nxt.pm * tstep : cA; const char* nB = has_next ? (const char*)g.Bt + (size_t)nxt.pn * tstep : cB;
        for (int t = 0; t < nt; t += 2) {
            const bool last = (t == nt - 2);
            const char* a1 = cA + (size_t)(t + 1) * kstep;
            const char* a2 = last ? nA : cA + (size_t)(t + 2) * kstep; const char* b2 = last ? nB : cB + (size_t)(t + 2) * kstep;
            const char* a3 = a2 + kstep; const char* b3 = b2 + kstep;
            if (last && has_next) S.a_ready(nxt);
            if constexpr (SP2) {
            PG8_LDB(B0, 0, 0); PG8_LDB(B1, 0, 1); PG8_SCHED; PG8_LDA(At, 0, 0); PG8_STAGE(PG8_SA(1, 1), a1 + hstep, voffA);
            PG8_WAIT_V(8); PG8_WAIT_L(0); PG8_BAR; PG8_MMA(0, 0, At, B0); PG8_MMA(0, 1, At, B1); PG8_BAR; PG8_SCHED;
            PG8_LDA(At, 0, 1); PG8_STAGE(PG8_SB(0, 0), b2, voffB); PG8_STAGE(PG8_SB(0, 1), b2 + hstep, voffB); PG8_STAGE(PG8_SA(0, 0), a2, voffA);
            PG8_WAIT_V(8); PG8_WAIT_L(0); PG8_BAR; PG8_MMA(1, 0, At, B0); PG8_MMA(1, 1, At, B1); PG8_BAR; PG8_SCHED;
            PG8_LDB(B0, 1, 0); PG8_LDB(B1, 1, 1); PG8_SCHED; PG8_LDA(At, 1, 0); PG8_STAGE(PG8_SA(0, 1), a2 + hstep, voffA);
            PG8_WAIT_V(8); PG8_WAIT_L(0); PG8_BAR; PG8_MMA(0, 0, At, B0); PG8_MMA(0, 1, At, B1); PG8_BAR; PG8_SCHED;
            PG8_LDA(At, 1, 1); PG8_STAGE(PG8_SB(1, 0), b3, voffB); PG8_STAGE(PG8_SB(1, 1), b3 + hstep, voffB); PG8_STAGE(PG8_SA(1, 0), a3, voffA);
            PG8_WAIT_V(8); PG8_WAIT_L(0); PG8_BAR; PG8_MMA(1, 0, At, B0); PG8_MMA(1, 1, At, B1); PG8_BAR; PG8_SCHED;
            } else {
            PG8_LDB(B0, 0, 0); PG8_SCHED; PG8_LDA(At, 0, 0); PG8_STAGE(PG8_SA(1, 1), a1 + hstep, voffA);
            PG8_WAIT_L(8); PG8_BAR; PG8_WAIT_L(0); PG8_MMA(0, 0, At, B0); PG8_BAR; PG8_SCHED;
            PG8_LDB(B1, 0, 1); PG8_STAGE(PG8_SB(0, 0), b2, voffB);
            PG8_BAR; PG8_WAIT_L(0); PG8_MMA(0, 1, At, B1); PG8_BAR;
            PG8_LDA(At, 0, 1); PG8_STAGE(PG8_SA(0, 0), a2, voffA);
            PG8_BAR; PG8_WAIT_L(0); PG8_MMA(1, 0, At, B0); PG8_BAR; PG8_SCHED;
            PG8_STAGE(PG8_SB(0, 1), b2 + hstep, voffB);
            PG8_WAIT_V(6); PG8_BAR; PG8_MMA(1, 1, At, B1); PG8_BAR;
            PG8_LDB(B0, 1, 0); PG8_SCHED; PG8_LDA(At, 1, 0); PG8_STAGE(PG8_SA(0, 1), a2 + hstep, voffA);
            PG8_WAIT_L(8); PG8_BAR; PG8_WAIT_L(0); PG8_MMA(0, 0, At, B0); PG8_BAR; PG8_SCHED;
            PG8_LDB(B1, 1, 1); PG8_STAGE(PG8_SB(1, 0), b3, voffB);
            PG8_BAR; PG8_WAIT_L(0); PG8_MMA(0, 1, At, B1); PG8_BAR;
            PG8_LDA(At, 1, 1); PG8_STAGE(PG8_SA(1, 0), a3, voffA);
            PG8_BAR; PG8_WAIT_L(0); PG8_MMA(1, 0, At, B0); PG8_BAR; PG8_SCHED;
            PG8_STAGE(PG8_SB(1, 1), b3 + hstep, voffB);
            PG8_WAIT_V(6); PG8_BAR; PG8_MMA(1, 1, At, B1); PG8_BAR;
            }
        }
        if constexpr (ALIGN_EPI) { if (wr == 0) PG8_BAR; }
        if constexpr (!Epi::AFTER_DRAIN) { const int l2 = fresh_lane(); E(acc, cur, wr, wc, l2 & 15, l2 >> 4); S.done(cur); }
        if (!has_next) break;
#pragma unroll
        for (int a = 0; a < 2; ++a)
#pragma unroll
            for (int b = 0; b < 2; ++b)
#pragma unroll
                for (int m = 0; m < 4; ++m)
#pragma unroll
                    for (int n = 0; n < 2; ++n) acc[a][b][m][n] = (f32x4){0.f, 0.f, 0.f, 0.f};
        cur = nxt; cA = nA; cB = nB; ++ui;
        if constexpr (ALIGN_EPI) { if (wr == 1) PG8_BAR; }
    }
    PG8_WAIT_V(0);
    if constexpr (!ALIGN_EPI) { if (wr == 0) PG8_BAR; }
    PG8_BAR;
#undef PG8_SA
#undef PG8_SB
#undef PG8_STAGE
#undef PG8_LDA
#undef PG8_LDB
#undef PG8_MMA
#undef PG8_WAIT_V
#undef PG8_WAIT_L
#undef PG8_BAR
#undef PG8_SCHED
}
}

#define XB_TMO      128
#define XB_XCNT(j)  (256  + 64 * (j))
#define XB_XSUB(j)  (1280 + 64 * (j))
#define XB_XGEN(j)  (2304 + 64 * (j))
#define XB_TOP      3328
#define XB_TOPGEN   3392
#define XCD_BAR_WORDS 3456
#define XB_SPIN_CAP (1u << 18)
__device__ __forceinline__ unsigned xb_ld(unsigned* p)              { return __hip_atomic_load(p, __ATOMIC_RELAXED, __HIP_MEMORY_SCOPE_AGENT); }
__device__ __forceinline__ unsigned xb_add(unsigned* p, unsigned v) { return __hip_atomic_fetch_add(p, v, __ATOMIC_RELAXED, __HIP_MEMORY_SCOPE_AGENT); }
__device__ __forceinline__ unsigned xb_xcc_id() { return (unsigned)__builtin_amdgcn_s_getreg((3 << 11) | 20) & 0xFu; }
#define XB_SPIN(cond, bar) do { unsigned _sp = 0; while (cond) { __builtin_amdgcn_s_sleep(1); \
    if ((++_sp & 255u) == 0u) { if (xb_ld(&(bar)[XB_TMO])) break; if (_sp > XB_SPIN_CAP) { atomicAdd(&(bar)[XB_TMO], 1u); break; } } } } while (0)
struct XcdBarrier { unsigned* bar; unsigned x; volatile LAS unsigned* st; };
__device__ __forceinline__ XcdBarrier xcd_barrier_post(unsigned* bar, volatile LAS unsigned* st) {
    XcdBarrier b; b.bar = bar; b.x = xb_xcc_id(); b.st = st;
    if (threadIdx.x == 0) (void)xb_add(&bar[XB_XCNT(b.x)], 1u);
    return b;
}
__device__ __forceinline__ void xcd_barrier_complete(unsigned* bar, unsigned x, unsigned& nloc, unsigned& nx) {
    const unsigned G = gridDim.x * gridDim.y * gridDim.z;
    unsigned sum, cnt, mine, sp = 0u;
    for (;;) {
        sum = 0u; cnt = 0u; mine = 0u;
#pragma unroll
        for (unsigned j = 0; j < 16; ++j) { const unsigned c = xb_ld(&bar[XB_XCNT(j)]); sum += c; cnt += (c > 0u) ? 1u : 0u; mine = (j == x) ? c : mine; }
        if (sum == G) break;
        __builtin_amdgcn_s_sleep(1);
        if ((++sp & 255u) == 0u) { if (xb_ld(&bar[XB_TMO])) break; if (sp > XB_SPIN_CAP) { atomicAdd(&bar[XB_TMO], 1u); break; } }
    }
    nloc = mine > 0u ? mine : 1u; nx = cnt > 0u ? cnt : 1u;
}
__device__ __forceinline__ void xcd_barrier(const XcdBarrier& b) {
    asm volatile("s_waitcnt vmcnt(0)" ::: "memory");
    __syncthreads();
    if (threadIdx.x == 0) {
        unsigned* bar = b.bar;
        __builtin_amdgcn_s_waitcnt(0);
        unsigned nloc = b.st[0], nx = b.st[1];
        if (nloc == 0u) { xcd_barrier_complete(bar, b.x, nloc, nx); b.st[0] = nloc; b.st[1] = nx; }
        const unsigned old = xb_add(&bar[XB_XSUB(b.x)], 1u);
        const unsigned gen = old / nloc;
        if (old + 1u == (gen + 1u) * nloc) {
            __builtin_amdgcn_fence(__ATOMIC_RELEASE, "agent");
            asm volatile("s_waitcnt vmcnt(0)" ::: "memory");
            const unsigned og = xb_add(&bar[XB_TOP], 1u);
            const unsigned tg = og / nx;
            if (og + 1u == (tg + 1u) * nx) xb_add(&bar[XB_TOPGEN], 1u);
            else XB_SPIN(xb_ld(&bar[XB_TOPGEN]) == tg, bar);
            __builtin_amdgcn_fence(__ATOMIC_ACQUIRE, "agent");
            xb_add(&bar[XB_XGEN(b.x)], 1u);
            asm volatile("s_waitcnt vmcnt(0)" ::: "memory");
        } else {
            XB_SPIN(xb_ld(&bar[XB_XGEN(b.x)]) == gen, bar);
            __builtin_amdgcn_fence(__ATOMIC_ACQUIRE, "agent");
            asm volatile("s_waitcnt vmcnt(0)" ::: "memory");
        }
    }
    __syncthreads();
}

struct Frame {
    LAS unsigned char* lds;
    int tid, lane, wave, vcu, G;
    const float *x, *p; const int* pos;
    const float *g_mix, *w_in, *lq1, *lk1, *lq2, *lk2, *g_subln, *ln_g, *ln_b, *w_sp, *b_sp, *w_out, *g_ffn, *w_up, *conv_w, *conv_b, *w_down, *g_ple, *w_gate, *w_pup, *g_final;
    float* out; unsigned char* ws;
};

__device__ __forceinline__ void conv_load(const float* W, int N, int item, int lane, f32x4 (&v)[16]) {
    const int nblk = N / 64, kb = item / nblk, nb = item % nblk, k0 = 64 * kb, n0 = 64 * nb;
    const int lr = lane >> 4, lc = (lane & 15) * 4;
    const float* src = W + (size_t)(k0 + lr) * N + n0 + lc;
#pragma unroll
    for (int i = 0; i < 16; ++i) v[i] = __builtin_nontemporal_load((const f32x4*)(src + (size_t)(4 * i) * N));
}
template <int MODE>
__device__ __forceinline__ void conv_store(f32x4 (&v)[16], int K, int N, bf16_t* WT, LAS float* scr, int item, int lane, const float* gk = nullptr) {
    const int nblk = N / 64, kb = item / nblk, nb = item % nblk, k0 = 64 * kb, n0 = 64 * nb;
    const int lr = lane >> 4, lc = (lane & 15) * 4;
#pragma unroll
    for (int i = 0; i < 16; ++i) { if (gk) v[i] = v[i] * gk[k0 + 4 * i + lr];
        LAS float* d = scr + (4 * i + lr) * 65 + lc; d[0] = v[i][0]; d[1] = v[i][1]; d[2] = v[i][2]; d[3] = v[i][3]; }
    LDS_WAIT(); asm volatile("" ::: "memory");
    int r0 = n0;
    if (MODE == 1) { const int isu = n0 >= DFF ? 1 : 0, ch = n0 - isu * DFF; r0 = (ch >> 7) * 256 + isu * 128 + (ch & 127); }
    const int c = lane & 7;
#pragma unroll
    for (int j = 0; j < 8; ++j) { const int n = (lane >> 3) + 8 * j; const LAS float* sp = scr + (8 * c) * 65 + n;
        u32x4 o; o.x = pk2(sp[0], sp[65]); o.y = pk2(sp[2 * 65], sp[3 * 65]); o.z = pk2(sp[4 * 65], sp[5 * 65]); o.w = pk2(sp[6 * 65], sp[7 * 65]);
        *(u32x4*)(WT + (size_t)(r0 + n) * K + k0 + 8 * c) = o; }
    LDS_WAIT(); asm volatile("" ::: "memory");
}
template <int MODE>
__device__ __forceinline__ void conv_item(const float* W, int K, int N, bf16_t* WT, LAS float* scr, int item, int lane, const float* gk = nullptr) {
    f32x4 v[16]; conv_load(W, N, item, lane, v); conv_store<MODE>(v, K, N, WT, scr, item, lane, gk);
}
template <int MODE>
__device__ __forceinline__ void conv_pair(const float* W, int K, int N, bf16_t* WT, LAS float* scr, int item, int lane, const float* gk = nullptr) {
    f32x4 va[16], vb[16]; conv_load(W, N, item, lane, va); conv_load(W, N, item + 1, lane, vb);
    conv_store<MODE>(va, K, N, WT, scr, item, lane, gk); conv_store<MODE>(vb, K, N, WT, scr, item + 1, lane, gk);
}
constexpr int IT_OUT = (DM / 64) * (DM / 64), IT_UP = (DM / 64) * (NUP / 64), IT_DN = (DFF / 64) * (DM / 64), IT_G = IT_OUT;
constexpr int SEG_A_ITEMS = IT_OUT + IT_UP, SEG_B_ITEMS = IT_DN + IT_G;
__device__ __forceinline__ unsigned q_ld(unsigned* p) { return __hip_atomic_load(p, __ATOMIC_RELAXED, __HIP_MEMORY_SCOPE_AGENT); }
__device__ __forceinline__ unsigned q_add(unsigned* p, unsigned v) { return __hip_atomic_fetch_add(p, v, __ATOMIC_RELAXED, __HIP_MEMORY_SCOPE_AGENT); }
__device__ __forceinline__ void conv_drain(Frame& F, int seg, unsigned done_target) {
    LAS float* scr = (LAS float*)(F.lds + F.wave * CONV_LDS_PER_WAVE);
    unsigned char* ws = F.ws; unsigned* ctl = (unsigned*)(ws + WS_CTL);
    unsigned* q = ctl + (seg ? CW_QB : CW_QA); unsigned* dn = ctl + (seg ? CW_DONE4 : CW_DONE1);
    const int nit = seg ? SEG_B_ITEMS : SEG_A_ITEMS, per = nit / 8;
    const int home = (int)(blockIdx.x & 7);
    for (int ss = 0; ss < 8; ++ss) {
        const int sh = (home + ss) & 7; unsigned* qh = q + 64 * sh;
        for (;;) {
            if (done_target) { if ((unsigned)__builtin_amdgcn_readfirstlane((int)q_ld(dn)) >= done_target) return; }
            if ((int)__builtin_amdgcn_readfirstlane((int)q_ld(qh)) >= per) break;
            unsigned i0 = 0; if (F.lane == 0) i0 = q_add(qh, 2u);
            i0 = (unsigned)__builtin_amdgcn_readfirstlane((int)i0);
            if ((int)i0 >= per) break;
            { const int it = sh * per + (int)i0;
                if (seg == 0) { if (it < IT_OUT) conv_pair<0>(F.w_out, DM, DM, (bf16_t*)(ws + WS_WOUTT), scr, it, F.lane); else conv_pair<1>(F.w_up, DM, NUP, (bf16_t*)(ws + WS_WUPT), scr, it - IT_OUT, F.lane, F.g_ffn); }
                else { if (it < IT_DN) conv_pair<0>(F.w_down, DFF, DM, (bf16_t*)(ws + WS_WDT), scr, it, F.lane); else conv_pair<0>(F.w_gate, DM, DM, (bf16_t*)(ws + WS_WGT), scr, it - IT_DN, F.lane, F.g_ple); } }
        }
    }
}
static_assert(SEG_A_ITEMS % 16 == 0 && SEG_B_ITEMS % 16 == 0 && IT_OUT % 2 == 0 && IT_DN % 2 == 0, "queue shards / item pairs");
__device__ __forceinline__ void p0_prologue(Frame& F) {
    LAS float* scr = (LAS float*)(F.lds + F.wave * CONV_LDS_PER_WAVE);
    const int gw = F.vcu * 8 + F.wave, NGW = F.G * 8;
    unsigned char* ws = F.ws;
    constexpr int I_IN = (DM / 64) * (NIN / 64), I_PU = (PLE / 64) * (DM / 64);
    for (int it = gw; it < I_IN + I_PU; it += 2 * NGW) {
        const int it2 = it + NGW; const bool two = it2 < I_IN + I_PU;
        f32x4 va[16], vb[16];
        if (it < I_IN) conv_load(F.w_in, NIN, it, F.lane, va); else conv_load(F.w_pup, DM, it - I_IN, F.lane, va);
        if (two) { if (it2 < I_IN) conv_load(F.w_in, NIN, it2, F.lane, vb); else conv_load(F.w_pup, DM, it2 - I_IN, F.lane, vb); }
        if (it < I_IN) conv_store<0>(va, DM, NIN, (bf16_t*)(ws + WS_WINT), scr, it, F.lane); else conv_store<0>(va, PLE, DM, (bf16_t*)(ws + WS_WPUT), scr, it - I_IN, F.lane);
        if (two) { if (it2 < I_IN) conv_store<0>(vb, DM, NIN, (bf16_t*)(ws + WS_WINT), scr, it2, F.lane); else conv_store<0>(vb, PLE, DM, (bf16_t*)(ws + WS_WPUT), scr, it2 - I_IN, F.lane); }
    }
    bf16_t* A0 = (bf16_t*)(ws + WS_A);
    {
        f32x4 v[8], nv[8];
        int m = gw;
        if (m < MTOK) { const f32x4* xr = (const f32x4*)(F.x + (size_t)m * DM) + F.lane;
#pragma unroll
            for (int j = 0; j < 8; ++j) nv[j] = __builtin_nontemporal_load(xr + 64 * j); }
        for (; m < MTOK; m += NGW) {
#pragma unroll
            for (int j = 0; j < 8; ++j) v[j] = nv[j];
            if (m + NGW < MTOK) { const f32x4* xr = (const f32x4*)(F.x + (size_t)(m + NGW) * DM) + F.lane;
#pragma unroll
                for (int j = 0; j < 8; ++j) nv[j] = __builtin_nontemporal_load(xr + 64 * j); }
            float s = 0.f;
#pragma unroll
            for (int j = 0; j < 8; ++j) s += pg8::dot4(v[j]);
            const float sd = sqrtf(wave_sum(s) * (1.0f / DM) + EPS), rstd = 1.0f / sd;
            if (F.lane == 0) ((float*)(ws + WS_SSQ))[3 * MTOK + m] = sd;
            u32x2* o8 = (u32x2*)(A0 + (size_t)m * DM) + F.lane;
#pragma unroll
            for (int j = 0; j < 8; ++j) { const f32x4 gq = *((const f32x4*)F.g_mix + F.lane + 64 * j); const f32x4 y = v[j] * rstd * gq; u32x2 w; w.x = pk2(y[0], y[1]); w.y = pk2(y[2], y[3]); o8[64 * j] = w; }
        }
    }
    {
        const int gt = F.vcu * 512 + F.tid, NGT = F.G * 512;
        bf16_t* PB = (bf16_t*)(ws + WS_PB);
        for (int i = gt; i < MTOK * PLE / 4; i += NGT) { const f32x4 v = __builtin_nontemporal_load((const f32x4*)F.p + i); u32x2 w; w.x = pk2(v[0], v[1]); w.y = pk2(v[2], v[3]); *((u32x2*)PB + i) = w; }
        float* rope = (float*)(ws + WS_ROPE);
        for (int i = gt; i < MTOK * 8; i += NGT) {
            const int row = i >> 3, fi = i & 7;
            const float invf = (float)exp2(-(double)fi * (18.931568569324174 / 8.0));
            const float ang = (float)F.pos[row] * invf;
            const double a = (double)ang, kq = rint(a * 0.63661977236758134);
            const double r = fma(-kq, 1.5707963267948966, a) - kq * 6.123233995736766e-17;
            const double r2 = r * r;
            const double sn = r + r * r2 * (-1.0 / 6 + r2 * (1.0 / 120 + r2 * (-1.0 / 5040 + r2 * (1.0 / 362880 + r2 * (-1.0 / 39916800)))));
            const double cs = 1.0 + r2 * (-0.5 + r2 * (1.0 / 24 + r2 * (-1.0 / 720 + r2 * (1.0 / 40320 + r2 * (-1.0 / 3628800 + r2 * (1.0 / 479001600))))));
            const int qd = ((int)kq) & 3;
            const double sv = (qd == 0) ? sn : (qd == 1) ? cs : (qd == 2) ? -sn : -cs;
            const double cv = (qd == 0) ? cs : (qd == 1) ? -sn : (qd == 2) ? -cs : sn;
            rope[(size_t)row * 16 + fi] = (float)cv; rope[(size_t)row * 16 + 8 + fi] = (float)sv;
        }
        float* ssq = (float*)(ws + WS_SSQ);
        for (int i = gt; i < 3 * MTOK; i += NGT) ssq[i] = 0.f;
    }
}

__device__ __forceinline__ int crow(int r, int hi) { return (r & 3) + 8 * (r >> 2) + 4 * hi; }
__device__ __forceinline__ s16x4 vtr(const LAS unsigned char* p) { typedef short v4i16_t __attribute__((ext_vector_type(4))); return __builtin_bit_cast(s16x4, __builtin_amdgcn_ds_read_tr16_b64_v4i16((LAS v4i16_t*)p)); }
#define MF32(a, b, c) __builtin_amdgcn_mfma_f32_32x32x16_bf16((a), (b), (c), 0, 0, 0)
__device__ __forceinline__ void glds16(const void* gsrc, unsigned lds_dst) { unsigned keep;
    asm volatile("s_mov_b32 %0, m0\n\ts_mov_b32 m0, %2\n\ts_nop 0\n\tglobal_load_lds_dwordx4 %1, off\n\ts_mov_b32 m0, %0" : "=&s"(keep) : "v"(gsrc), "s"(lds_dst) : "memory"); }
constexpr float ATT_THR = 8.0f;
__device__ __forceinline__ float rowmax32(const f32x16& a, const f32x16& b) {
    float x = fmaxf(fmaxf(a[0], a[1]), a[2]), y = fmaxf(fmaxf(b[0], b[1]), b[2]);
#pragma unroll
    for (int r = 3; r < 15; r += 2) { x = fmaxf(fmaxf(x, a[r]), a[r + 1]); y = fmaxf(fmaxf(y, b[r]), b[r + 1]); }
    x = fmaxf(fmaxf(x, a[15]), fmaxf(y, b[15]));
    return fmaxf(x, __shfl_xor(x, 32));
}
__device__ __forceinline__ void att_qk(f32x16& n0, f32x16& n1, const LAS unsigned char* kb, const bf16x8 (&qr)[4]) {
    n0 = (f32x16){}; n1 = (f32x16){};
#pragma unroll
    for (int d0 = 0; d0 < 4; ++d0) {
        const bf16x8 a0 = *(const LAS bf16x8*)(kb + d0 * 2048), a1 = *(const LAS bf16x8*)(kb + d0 * 2048 + 512);
        n0 = MF32(a0, qr[d0], n0); n1 = MF32(a1, qr[d0], n1); }
}
__device__ __forceinline__ float fadd_s(float a, float b) { float r; asm("v_add_f32_e32 %0, %1, %2" : "=v"(r) : "v"(a), "v"(b)); return r; }
__device__ __forceinline__ float fmax3_s(float a, float b, float c) { float r; asm("v_max3_f32 %0, %1, %2, %3" : "=v"(r) : "v"(a), "v"(b), "v"(c)); return r; }
__device__ __forceinline__ float fmax_s(float a, float b) { float r; asm("v_max_f32_e32 %0, %1, %2" : "=v"(r) : "v"(a), "v"(b)); return r; }
#define ATT_SBAR() __builtin_amdgcn_sched_barrier(0)
#ifndef ATT_VPF
#define ATT_VPF 3
#endif
__device__ __forceinline__ u32x4 att_pack8(const f32x16& x, int b) { return (u32x4){pk2(x[b], x[b + 1]), pk2(x[b + 2], x[b + 3]), pk2(x[b + 4], x[b + 5]), pk2(x[b + 6], x[b + 7])}; }
template <bool TRACK, bool HAS_CUR, bool HAS_NEXT>
__device__ __forceinline__ void att_step(f32x16 (&o)[4], f32x16& e0, f32x16& e1, f32x16& c0, f32x16& c1, float& m, float& l, f32x16& negm,
                                         const bf16x8 (&qr)[4], const LAS unsigned char* kb_next, const LAS unsigned char* vb_prev, LAS float* wsf, int r32, int hi) {
    float mx0 = (TRACK && HAS_CUR) ? c0[0] : 0.f, mx1 = (TRACK && HAS_CUR) ? c1[0] : 0.f, s0 = e0[0], s1 = e1[0];
    {
        constexpr int VPF = TRACK ? 2 : ATT_VPF, NB = VPF + 1;
        s16x4 flo[NB], fhi[NB]; u32x4 pw;
#define ATT_VRD(i, slot) do { flo[slot] = vtr(vb_prev + ((((i) & 3) * 4) + ((i) >> 2)) * 1024); fhi[slot] = vtr(vb_prev + ((((i) & 3) * 4) + ((i) >> 2)) * 1024 + 512); } while (0)
#pragma unroll
        for (int i = 0; i < VPF; ++i) ATT_VRD(i, i);
#pragma unroll
        for (int i = 0; i < 16; ++i) {
            if (i + VPF < 16) ATT_VRD(i + VPF, (i + VPF) % NB);
            if ((i & 3) == 0) { const int ks = i >> 2; pw = (ks < 2) ? att_pack8(e0, 8 * (ks & 1)) : att_pack8(e1, 8 * (ks & 1)); }
            const bf16x8 vf = (bf16x8){flo[i % NB][0], flo[i % NB][1], flo[i % NB][2], flo[i % NB][3], fhi[i % NB][0], fhi[i % NB][1], fhi[i % NB][2], fhi[i % NB][3]};
            o[i & 3] = MF32(__builtin_bit_cast(bf16x8, pw), vf, o[i & 3]);
            if (i > 0) { s0 = fadd_s(s0, e0[i]); s1 = fadd_s(s1, e1[i]); }
            if (TRACK && HAS_CUR && i > 0) { if (i & 1) mx0 = fmax3_s(mx0, c0[i], c1[i]); else mx1 = fmax3_s(mx1, c0[i], c1[i]); }
            ATT_SBAR();
        }
#undef ATT_VRD
    }
    l += s0 + s1;
    if (HAS_CUR) {
        float rm = fmaxf(mx0, mx1); if (TRACK) rm = fmaxf(rm, __shfl_xor(rm, 32));
        if (TRACK && __any(rm > ATT_THR)) {
            const float dl = fmaxf(rm, 0.f), alpha = __builtin_amdgcn_exp2f(-dl); m += dl; l *= alpha;
#pragma unroll
            for (int r = 0; r < 16; ++r) { c0[r] -= dl; c1[r] -= dl; negm[r] = -m; }
            if (hi == 0) wsf[r32] = alpha;
            LDS_WAIT();
#pragma unroll
            for (int r = 0; r < 16; ++r) { const float ar = wsf[crow(r, hi)];
#pragma unroll
                for (int d = 0; d < 4; ++d) o[d][r] *= ar; }
        }
        ATT_SBAR();
        if (HAS_NEXT) {
            bf16x8 ka[2], kc[2];
            ka[0] = *(const LAS bf16x8*)(kb_next); kc[0] = *(const LAS bf16x8*)(kb_next + 512);
#pragma unroll
            for (int d0 = 0; d0 < 4; ++d0) {
                if (d0 < 3) { ka[(d0 + 1) & 1] = *(const LAS bf16x8*)(kb_next + (d0 + 1) * 2048); kc[(d0 + 1) & 1] = *(const LAS bf16x8*)(kb_next + (d0 + 1) * 2048 + 512); }
                if (d0 == 0) e0 = MF32(ka[0], qr[0], negm); else e0 = MF32(ka[d0 & 1], qr[d0], e0);
#pragma unroll
                for (int r = 4 * d0; r < 4 * d0 + 4; ++r) c0[r] = __builtin_amdgcn_exp2f(c0[r]);
                ATT_SBAR();
                if (d0 == 0) e1 = MF32(kc[0], qr[0], negm); else e1 = MF32(kc[d0 & 1], qr[d0], e1);
#pragma unroll
                for (int r = 4 * d0; r < 4 * d0 + 4; ++r) c1[r] = __builtin_amdgcn_exp2f(c1[r]);
                ATT_SBAR();
            }
        } else {
#pragma unroll
            for (int r = 0; r < 16; ++r) { c0[r] = __builtin_amdgcn_exp2f(c0[r]); c1[r] = __builtin_amdgcn_exp2f(c1[r]); }
        }
        asm volatile("" : "+v"(c0), "+v"(c1));
        ATT_SBAR();
    }
}
__device__ __forceinline__ void att_qk_c(f32x16& n0, f32x16& n1, const LAS unsigned char* kb, const bf16x8 (&qr)[4], const f32x16& negm) {
#pragma unroll
    for (int d0 = 0; d0 < 4; ++d0) {
        const bf16x8 a0 = *(const LAS bf16x8*)(kb + d0 * 2048), a1 = *(const LAS bf16x8*)(kb + d0 * 2048 + 512);
        if (d0 == 0) { n0 = MF32(a0, qr[0], negm); n1 = MF32(a1, qr[0], negm); } else { n0 = MF32(a0, qr[d0], n0); n1 = MF32(a1, qr[d0], n1); } }
}
constexpr float ATT_HEADROOM = 64.0f;
#ifndef ATT_FAST_TRACK
#define ATT_FAST_TRACK false
#endif
template <bool TRACK>
__device__ __forceinline__ bool attn_unit(int b, int h, int qb, const bf16_t* Qg, const bf16_t* Kg, const bf16_t* Vg, bf16_t* MIX, const float* g_subln, float lam, LAS unsigned char* lds) {
    const int tid = threadIdx.x, lane = tid & 63, r32 = lane & 31, hi = lane >> 5;
    const int wid = __builtin_amdgcn_readfirstlane(tid >> 6), c = wid >> 2, wq = wid & 3;
    const size_t rowbase = (size_t)b * SEQ; const int q0 = qb * 128 + wq * 32;
    constexpr int NT = SEQ / 64;
    bf16x8 qr[4];
    { const bf16_t* qp = Qg + (rowbase + q0 + r32) * PARTW + h * 128 + c * 64 + hi * 8;
#pragma unroll
      for (int d0 = 0; d0 < 4; ++d0) qr[d0] = *(const bf16x8*)(qp + d0 * 16); }
    const bf16_t* ksrc = Kg + (rowbase + lane) * PARTW + h * 128;
    const bf16_t* vsrc = Vg + (rowbase + (lane >> 2)) * PARTW + h * 128 + (lane & 3) * 8;
    const unsigned lds0 = (unsigned)(uintptr_t)lds;
#define AT_KSLOT(s) ((s) * 16384)
#define AT_VSLOT(s) (49152 + (s) * 16384)
#define AT_DMA_K(t, s) do { _Pragma("unroll") for (int _i = 0; _i < 2; ++_i) { const int kc = wid + 8 * _i; \
        glds16(ksrc + (size_t)(t) * 64 * PARTW + kc * 8, (unsigned)__builtin_amdgcn_readfirstlane((int)(lds0 + AT_KSLOT(s) + kc * 1024))); } } while (0)
#define AT_DMA_V(t, s) do { _Pragma("unroll") for (int _i = 0; _i < 2; ++_i) { const int pi = wid + 8 * _i, d0v = pi >> 2, kg = pi & 3; \
        glds16(vsrc + ((size_t)(t) * 64 + kg * 16) * PARTW + d0v * 32, (unsigned)__builtin_amdgcn_readfirstlane((int)(lds0 + AT_VSLOT(s) + pi * 1024))); } } while (0)
#define AT_WAITBAR() do { asm volatile("s_waitcnt vmcnt(0) lgkmcnt(0)" ::: "memory"); __builtin_amdgcn_s_barrier(); asm volatile("" ::: "memory"); } while (0)
    f32x16 o[4];
#pragma unroll
    for (int i = 0; i < 4; ++i) o[i] = (f32x16){};
    float mrow, lsum = 0.f;
    LAS float* wsf = (LAS float*)(lds + 98304) + wid * 64;
    const int koff = (c * 8 + hi) * 1024 + r32 * 16;
    const int voff = ((lane >> 4) & 1) * 32 + (lane & 3) * 8 + (4 * hi + ((lane & 15) >> 2)) * 64;
    f32x16 pA0, pA1, pB0, pB1;
    LAS unsigned* redo = (LAS unsigned*)(lds + LDSCTL_OFF + 320);
    if (!TRACK) { if (tid == 0) *redo = 0u; }
    AT_DMA_K(0, 0); AT_DMA_V(0, 0); AT_DMA_K(1, 1);
    AT_WAITBAR();
    AT_DMA_K(2, 2); AT_DMA_V(1, 1);
    f32x16 negm = (f32x16){};
    att_qk_c(pA0, pA1, lds + AT_KSLOT(0) + koff, qr, negm);
    mrow = rowmax32(pA0, pA1); if (!TRACK) mrow += ATT_HEADROOM;
#pragma unroll
    for (int r = 0; r < 16; ++r) negm[r] = -mrow;
    att_qk_c(pB0, pB1, lds + AT_KSLOT(1) + koff, qr, negm);
#pragma unroll
    for (int r = 0; r < 16; ++r) { pA0[r] = __builtin_amdgcn_exp2f(pA0[r] - mrow); pA1[r] = __builtin_amdgcn_exp2f(pA1[r] - mrow); }
    int sk = 2, sv = 0;
#define AT_TOP(t) do { AT_WAITBAR(); const int sk2 = (sk == 2) ? 0 : sk + 1;   \
        if ((t) + 2 < NT) AT_DMA_K((t) + 2, sk2); if ((t) + 1 < NT) AT_DMA_V((t) + 1, sk); } while (0)
#define AT_ADV() do { sk = (sk == 2) ? 0 : sk + 1; sv = (sv == 2) ? 0 : sv + 1; } while (0)
    for (int t = 1; t + 1 < NT; t += 2) {
        AT_TOP(t);
        att_step<TRACK, true, true>(o, pA0, pA1, pB0, pB1, mrow, lsum, negm, qr, lds + AT_KSLOT(sk) + koff, lds + AT_VSLOT(sv) + voff, wsf, r32, hi);
        AT_ADV();
        AT_TOP(t + 1);
        att_step<TRACK, true, true>(o, pB0, pB1, pA0, pA1, mrow, lsum, negm, qr, lds + AT_KSLOT(sk) + koff, lds + AT_VSLOT(sv) + voff, wsf, r32, hi);
        AT_ADV();
    }
    AT_TOP(NT - 1);
    att_step<TRACK, true, false>(o, pA0, pA1, pB0, pB1, mrow, lsum, negm, qr, lds + AT_KSLOT(sk) + koff, lds + AT_VSLOT(sv) + voff, wsf, r32, hi);
    AT_ADV();
    att_step<TRACK, false, false>(o, pB0, pB1, pA0, pA1, mrow, lsum, negm, qr, lds + AT_KSLOT(sk) + koff, lds + AT_VSLOT(sv) + voff, wsf, r32, hi);
    if (!TRACK) { if (__any(!(lsum < 0x1p100f))) { if ((lane & 63) == 0) *redo = 1u; } }
    LDS_WAIT(); __builtin_amdgcn_s_barrier(); asm volatile("" ::: "memory");
    if (!TRACK) { if (__builtin_amdgcn_readfirstlane((int)*redo) != 0) { __builtin_amdgcn_s_barrier(); return false; } }
    float lt = lsum + __shfl_xor(lsum, 32);
    float inv = 1.0f / lt; if (c == 1) inv *= lam;
    if (hi == 0) wsf[r32] = inv;
    LDS_WAIT();
#pragma unroll
    for (int r = 0; r < 16; ++r) { const float ar = wsf[crow(r, hi)];
#pragma unroll
        for (int d = 0; d < 4; ++d) o[d][r] *= ar; }
    LAS float* X = (LAS float*)lds + wq * 4096;
    if (c == 1) {
#pragma unroll
        for (int d = 0; d < 4; ++d)
#pragma unroll
            for (int r = 0; r < 16; ++r) X[(d * 16 + r) * 64 + lane] = o[d][r];
    }
    LDS_WAIT(); __builtin_amdgcn_s_barrier(); asm volatile("" ::: "memory");
    if (c == 0) {
        float gs[4];
#pragma unroll
        for (int d = 0; d < 4; ++d) gs[d] = g_subln[32 * d + r32] * (1.0f - LAMBDA_INIT);
        LAS bf16_t* stg = (LAS bf16_t*)(lds + 65536 + wq * 8192);
#pragma unroll
        for (int r = 0; r < 16; ++r) {
            float ss = 0.f;
#pragma unroll
            for (int d = 0; d < 4; ++d) { o[d][r] -= X[(d * 16 + r) * 64 + lane]; ss += o[d][r] * o[d][r]; }
            ss += __shfl_xor(ss, 1); ss += __shfl_xor(ss, 2); ss += __shfl_xor(ss, 4); ss += __shfl_xor(ss, 8); ss += __shfl_xor(ss, 16);
            const float rn = __builtin_amdgcn_rsqf(ss * (1.0f / 128.0f) + EPS);
#pragma unroll
            for (int d = 0; d < 4; ++d) stg[crow(r, hi) * 128 + 32 * d + r32] = (bf16_t)f2bf(o[d][r] * rn * gs[d]);
        }
        LDS_WAIT();
        bf16_t* ob = MIX + (rowbase + qb * 128 + wq * 32) * DM + h * 128;
#pragma unroll
        for (int i = 0; i < 8; ++i) { const int row = i * 4 + (lane >> 4), ch = lane & 15; *(u32x4*)(ob + (size_t)row * DM + ch * 8) = *(const LAS u32x4*)(stg + row * 128 + ch * 8); }
    }
    LDS_WAIT(); __builtin_amdgcn_s_barrier(); asm volatile("" ::: "memory");
#undef AT_DMA_K
#undef AT_DMA_V
#undef AT_TOP
#undef AT_ADV
#undef AT_WAITBAR
    return true;
}

__device__ __forceinline__ void gmlp_unit(int ck, int hh, const bf16_t* Ug, const bf16_t* Gg, const float* lnstat, const float* ln_g, const float* ln_b, const float* w_sp, const float* b_sp, bf16_t* MIX, LAS unsigned char* lds) {
    const int tid = threadIdx.x, lane = tid & 63; const int wid = __builtin_amdgcn_readfirstlane(tid >> 6);
    constexpr int LDW = 136;
    LAS bf16_t* Ws = (LAS bf16_t*)lds;
    LAS bf16_t* VT = (LAS bf16_t*)(lds + 128 * LDW * 2);
    const size_t row0 = (size_t)ck * 128;
    { const float* wp = w_sp + (size_t)hh * 128 * 128;
#pragma unroll
      for (int i = 0; i < 8; ++i) { const int e = (tid + 512 * i) * 4, pr = e >> 7, qc = e & 127; const f32x4 v = *(const f32x4*)(wp + e);
          u32x2 w; w.x = pk2(v[0], v[1]); w.y = pk2(v[2], v[3]); *(LAS u32x2*)(Ws + pr * LDW + qc) = w; } }
    { const int q = tid & 127, dg = tid >> 7;
      const float* st = lnstat + (row0 + q) * 32; float s = 0.f, sq = 0.f;
#pragma unroll
      for (int i = 0; i < 8; ++i) { const f32x4 t4 = *(const f32x4*)(st + 4 * i); s += t4[0] + t4[2]; sq += t4[1] + t4[3]; }
      const float mean = s * (1.0f / 1024.0f), var = fmaxf(sq * (1.0f / 1024.0f) - mean * mean, 0.f), rstd = 1.0f / sqrtf(var + EPS);
      const bf16_t* gp = Gg + (row0 + q) * PARTW + hh * 128 + dg * 32;
      const float* lg = ln_g + hh * 128 + dg * 32; const float* lb = ln_b + hh * 128 + dg * 32;
#pragma unroll
      for (int i = 0; i < 4; ++i) { const bf16x8 gv = *(const bf16x8*)(gp + 8 * i);
          const f32x4 g0 = *(const f32x4*)(lg + 8 * i), g1 = *(const f32x4*)(lg + 8 * i + 4), b0 = *(const f32x4*)(lb + 8 * i), b1 = *(const f32x4*)(lb + 8 * i + 4);
#pragma unroll
          for (int j = 0; j < 8; ++j) { const int d = dg * 32 + 8 * i + j; const float gg = j < 4 ? g0[j & 3] : g1[j & 3], bbv = j < 4 ? b0[j & 3] : b1[j & 3];
              const float vn = (bf2f((unsigned short)gv[j]) - mean) * rstd * gg + bbv;
              VT[d * LDW + q] = (bf16_t)f2bf(vn); } } }
    LDS_WAIT(); __builtin_amdgcn_s_barrier(); asm volatile("" ::: "memory");
    f32x4 acc[8];
#pragma unroll
    for (int n = 0; n < 8; ++n) acc[n] = (f32x4){0.f, 0.f, 0.f, 0.f};
    const int fr = lane & 15, fq = lane >> 4;
#pragma unroll
    for (int ks = 0; ks < 4; ++ks) {
        const bf16x8 a = *(const LAS bf16x8*)(Ws + (16 * wid + fr) * LDW + 32 * ks + 8 * fq);
#pragma unroll
        for (int n = 0; n < 8; ++n) { const bf16x8 bb = *(const LAS bf16x8*)(VT + (16 * n + fr) * LDW + 32 * ks + 8 * fq);
            acc[n] = __builtin_amdgcn_mfma_f32_16x16x32_bf16(bb, a, acc[n], 0, 0, 0); }
    }
    { const int pr = 16 * wid + fr; const float bs = b_sp[hh * 128 + pr];
      const bf16_t* up = Ug + (row0 + pr) * PARTW + hh * 128 + 4 * fq; bf16_t* op = MIX + (row0 + pr) * DM + 1024 + hh * 128 + 4 * fq;
      u32x2 uv[8];
#pragma unroll
      for (int n = 0; n < 8; ++n) uv[n] = *(const u32x2*)(up + 16 * n);
#pragma unroll
      for (int n = 0; n < 8; ++n) { u32x2 w;
          w.x = pk2(__builtin_bit_cast(float, uv[n].x << 16) * (acc[n][0] + bs), __builtin_bit_cast(float, uv[n].x & 0xffff0000u) * (acc[n][1] + bs));
          w.y = pk2(__builtin_bit_cast(float, uv[n].y << 16) * (acc[n][2] + bs), __builtin_bit_cast(float, uv[n].y & 0xffff0000u) * (acc[n][3] + bs));
          *(u32x2*)(op + 16 * n) = w; } }
    LDS_WAIT(); __builtin_amdgcn_s_barrier(); asm volatile("" ::: "memory");
}

struct Args { const void* in[24]; float* out; unsigned char* ws; int ph_lo, ph_hi; };
constexpr int N_PHASES = 8;
__global__ void __launch_bounds__(512, 2) mk_fwd(Args args) {
    extern __shared__ __attribute__((aligned(16))) unsigned char lds_raw[];
    Frame F;
    F.lds = (LAS unsigned char*)lds_raw;
    F.tid = threadIdx.x; F.lane = F.tid & 63; F.wave = __builtin_amdgcn_readfirstlane(F.tid >> 6);
    F.G = gridDim.x; { const int bx = blockIdx.x; F.vcu = (F.G % 8 == 0) ? (bx % 8) * (F.G / 8) + bx / 8 : bx; }
    F.x = (const float*)args.in[0]; F.p = (const float*)args.in[1]; F.pos = (const int*)args.in[2]; F.g_mix = (const float*)args.in[3]; F.w_in = (const float*)args.in[4];
    F.lq1 = (const float*)args.in[5]; F.lk1 = (const float*)args.in[6]; F.lq2 = (const float*)args.in[7]; F.lk2 = (const float*)args.in[8]; F.g_subln = (const float*)args.in[9];
    F.ln_g = (const float*)args.in[10]; F.ln_b = (const float*)args.in[11]; F.w_sp = (const float*)args.in[12]; F.b_sp = (const float*)args.in[13]; F.w_out = (const float*)args.in[14];
    F.g_ffn = (const float*)args.in[15]; F.w_up = (const float*)args.in[16]; F.conv_w = (const float*)args.in[17]; F.conv_b = (const float*)args.in[18]; F.w_down = (const float*)args.in[19];
    F.g_ple = (const float*)args.in[20]; F.w_gate = (const float*)args.in[21]; F.w_pup = (const float*)args.in[22]; F.g_final = (const float*)args.in[23];
    F.out = args.out; F.ws = args.ws;
    unsigned char* ws = args.ws;
    for (int u = F.tid; u < 512 / 4; u += 512) ((LAS unsigned*)(F.lds + LDSCTL_OFF))[u] = 0u;
    __syncthreads();
    const int lo = args.ph_lo, hi = args.ph_hi;
    XcdBarrier bar; bar.bar = (unsigned*)(ws + WS_CTL) + CW_BAR; bar.x = 0; bar.st = nullptr;
    if (hi - lo > 1) bar = xcd_barrier_post((unsigned*)(ws + WS_CTL) + CW_BAR, (volatile LAS unsigned*)(F.lds + LDSCTL_OFF) + 8);
#ifndef PH_MASK
#define PH_MASK 0x1ff
#endif
#define IN(k) (((PH_MASK >> (k)) & 1) && lo <= (k) && (k) < hi)
#define SEAM(k) do { if (IN(k) && IN((k) + 1)) xcd_barrier(bar); } while (0)

    bf16_t* A = (bf16_t*)(ws + WS_A); bf16_t* HB1 = (bf16_t*)(ws + WS_A); bf16_t* HB2 = (bf16_t*)(ws + WS_H); float* SSQ = (float*)(ws + WS_SSQ);
    bf16_t* QKVUG = (bf16_t*)(ws + WS_QKVUG); bf16_t* MIX = (bf16_t*)(ws + WS_MIX); bf16_t* ACT = (bf16_t*)(ws + WS_ACT);
    float* HALO = (float*)(ws + WS_HALO);

    if (IN(0)) { p0_prologue(F); }
    SEAM(0);
    if (IN(1)) {
        { pg8::Gemm g{A, (const bf16_t*)(ws + WS_WINT), MTOK, NIN, DM}; pg8::StaticOrder S; S.init(MTOK, NIN, F.G, (int)blockIdx.x);
          pg8::EpiIn E{QKVUG, (const float*)(ws + WS_ROPE), (float*)(ws + WS_LNST)};
          pg8::gemm_phase<pg8::EpiIn, pg8::StaticOrder, true, true>(F.lds, g, S, E); }
        if (F.G == 256) {
            if (blockIdx.x < 128) { if (F.tid == 0) (void)q_add((unsigned*)(ws + WS_CTL) + CW_DONE1, 1u); } else conv_drain(F, 0, 128u);
        }
    }
    SEAM(1);
    if (IN(2)) {
        const float s1 = wave_sum(F.lq1[F.lane] * F.lk1[F.lane]), s2 = wave_sum(F.lq2[F.lane] * F.lk2[F.lane]);
        const float lam = expf(s1) - expf(s2) + LAMBDA_INIT;
        for (int u = F.vcu; u < NBATCH * NHEAD * 16; u += F.G) { const int bh = u >> 4, qb = u & 15;
            if (!attn_unit<ATT_FAST_TRACK>(bh >> 3, bh & 7, qb, QKVUG, QKVUG + PART_ELEMS, QKVUG + 2 * PART_ELEMS, MIX, F.g_subln, lam, F.lds))
                (void)attn_unit<true>(bh >> 3, bh & 7, qb, QKVUG, QKVUG + PART_ELEMS, QKVUG + 2 * PART_ELEMS, MIX, F.g_subln, lam, F.lds); }
        for (int u = F.vcu; u < 64 * 8; u += F.G) { const int ck = u >> 3, hh = u & 7;
            gmlp_unit(ck, hh, QKVUG + 3 * PART_ELEMS, QKVUG + 4 * PART_ELEMS, (const float*)(ws + WS_LNST), F.ln_g, F.ln_b, F.w_sp, F.b_sp, MIX, F.lds); }
        conv_drain(F, 0, 0u);
    }
    SEAM(2);
    if (IN(3)) {
        pg8::Gemm g{MIX, (const bf16_t*)(ws + WS_WOUTT), MTOK, DM, DM}; pg8::StaticOrder S; S.init(MTOK, DM, F.G, (int)blockIdx.x);
        pg8::EpiResid<2> E{HB1, HB1, SSQ, SSQ + 3 * MTOK, F.g_mix};
        pg8::gemm_phase<pg8::EpiResid<2>, pg8::StaticOrder, true, true>(F.lds, g, S, E);
    }
    SEAM(3);
    if (IN(4)) {
        pg8::Gemm g{HB1, (const bf16_t*)(ws + WS_WUPT), MTOK, NUP, DM}; pg8::StaticOrder S; S.init(MTOK, NUP, F.G, (int)blockIdx.x);
        pg8::EpiConvGlu E{ACT, HALO, SSQ, F.conv_w, F.conv_b, F.lds + XLDS_OFF};
        pg8::gemm_phase<pg8::EpiConvGlu, pg8::StaticOrder, true, true>(F.lds, g, S, E);
        {
            const bool split = (F.G == 256), is_long = split && blockIdx.x < 128;
            pg8::SmallOrder S2;
            if (split) { S2.first = 2 * ((int)blockIdx.x - 128); S2.stride = 1; S2.count = is_long ? 0 : 2; }
            else { S2.first = (int)blockIdx.x; S2.stride = F.G; S2.count = ((int)blockIdx.x < 256) ? (256 - (int)blockIdx.x + F.G - 1) / F.G : 0; }
            int zero = 0; asm volatile("" : "+s"(zero));
            S2.first += zero;
            pg8::Gemm g2{(const bf16_t*)(ws + WS_PB), (const bf16_t*)(ws + WS_WPUT), MTOK, DM, PLE};
            pg8::EpiBf16 E2{(bf16_t*)(ws + WS_UPB), DM};
            pg8::gemm_phase<pg8::EpiBf16, pg8::SmallOrder, false, true>(F.lds, g2, S2, E2, zero);
            if (split) { if (is_long) { if (F.tid == 0) (void)q_add((unsigned*)(ws + WS_CTL) + CW_DONE4, 1u); } else conv_drain(F, 1, 128u); }
        }
    }
    SEAM(4);
    if (IN(5)) {
        const int gt = F.vcu * 512 + F.tid, NGT = F.G * 512;
        constexpr int NB = MTOK / 256 - 1;
        for (int i = gt; i < NB * 2 * DFF; i += NGT) {
            const int ch = i % DFF, w = (i / DFF) & 1, bnd = i / (2 * DFF) + 1;
            if ((bnd & 7) == 0) continue;
            const int pn = ch >> 7, cc = ch & 127; const size_t gi = (size_t)pn * 256 + cc, ui = gi + 128;
            const float* hA = HALO + (size_t)(bnd - 1) * 4 * NUP; const float* hB = HALO + (size_t)bnd * 4 * NUP;
            const float* rp = (w == 0) ? hA + 2 * NUP : hA + 3 * NUP;
            const float* rc = (w == 0) ? hA + 3 * NUP : hB;
            const float* rn = (w == 0) ? hB : hB + NUP;
            const float gq = F.conv_w[ch] * rp[gi] + F.conv_w[NUP + ch] * rc[gi] + F.conv_w[2 * NUP + ch] * rn[gi] + F.conv_b[ch];
            const float uq = F.conv_w[DFF + ch] * rp[ui] + F.conv_w[NUP + DFF + ch] * rc[ui] + F.conv_w[2 * NUP + DFF + ch] * rn[ui] + F.conv_b[DFF + ch];
            const size_t row = (size_t)bnd * 256 - 1 + w;
            ACT[row * DFF + ch] = (bf16_t)f2bf(gq * __builtin_amdgcn_rcpf(1.0f + __builtin_amdgcn_exp2f(gq * (-LOG2E))) * uq);
        }
        conv_drain(F, 1, 0u);
    }
    SEAM(5);
    if (IN(6)) {
        pg8::Gemm g{ACT, (const bf16_t*)(ws + WS_WDT), MTOK, DM, DFF}; pg8::StaticOrder S; S.init(MTOK, DM, F.G, (int)blockIdx.x);
        pg8::EpiResid<1> E{HB1, HB2, SSQ + MTOK, nullptr, nullptr};
        pg8::gemm_phase<pg8::EpiResid<1>, pg8::StaticOrder, true, true>(F.lds, g, S, E);
    }
    SEAM(6);
    if (IN(7)) {
        bf16_t* UPB = (bf16_t*)(ws + WS_UPB);
        int zero = 0; asm volatile("" : "+s"(zero));
        pg8::Gemm g{HB2, (const bf16_t*)(ws + WS_WGT), MTOK, DM, DM}; pg8::StaticOrder S; S.init(MTOK, DM, F.G, (int)blockIdx.x + zero);
        pg8::EpiPle<true> E{HB2, UPB, F.out, SSQ + MTOK, SSQ + 2 * MTOK, (unsigned*)(ws + WS_CTL) + CW_PANEL, F.g_final};
        pg8::gemm_phase<pg8::EpiPle<true>, pg8::StaticOrder, true, true>(F.lds, g, S, E, zero);
    }
#undef IN
#undef SEAM
}

extern "C" void kernel_launch(void* const* d_in, const int* in_sizes, int n_in, void* d_out, int out_size, void* d_ws, size_t ws_size, hipStream_t stream) {
    static int grid = 0;
    if (grid == 0) {
        if (n_in != 24 || in_sizes[0] != MTOK * DM || out_size != MTOK * DM || ws_size < WS_END) {
            fprintf(stderr, "kernel_launch: unexpected shapes: n_in %d in0 %d out %d ws %zu (need %zu)\n", n_in, n_in > 0 ? in_sizes[0] : -1, out_size, ws_size, (size_t)WS_END); grid = -1; return; }
        int dev = 0, cus = 0, per_cu = 0;
        if (hipGetDevice(&dev) != hipSuccess || hipDeviceGetAttribute(&cus, hipDeviceAttributeMultiprocessorCount, dev) != hipSuccess) { grid = -1; return; }
        if (hipFuncSetAttribute((const void*)mk_fwd, hipFuncAttributeMaxDynamicSharedMemorySize, LDS_BYTES) != hipSuccess) { fprintf(stderr, "kernel_launch: hipFuncSetAttribute failed\n"); grid = -1; return; }
        if (hipOccupancyMaxActiveBlocksPerMultiprocessor(&per_cu, (const void*)mk_fwd, 512, LDS_BYTES) != hipSuccess || per_cu < 1) { fprintf(stderr, "kernel_launch: occupancy query says %d blocks/CU\n", per_cu); per_cu = 1; }
        (void)hipGetLastError();
        if (cus != 256) fprintf(stderr, "kernel_launch: built for a 256-CU device (one 256 x 256 unit per workgroup in the fused final-norm phase); this device has %d CUs: the output will be wrong\n", cus);
        grid = cus;
    }
    if (grid < 0) return;
    (void)hipMemsetAsync((char*)d_ws + WS_CTL, 0, CTL_ZERO_BYTES, stream);
    Args a{};
    for (int i = 0; i < 24; ++i) a.in[i] = d_in[i];
    a.out = (float*)d_out; a.ws = (unsigned char*)d_ws;
#if MK_N_LAUNCHES == 1
    a.ph_lo = 0; a.ph_hi = N_PHASES;
    hipLaunchKernelGGL(mk_fwd, dim3(grid), dim3(512), LDS_BYTES, stream, a);
#else
    for (int li = 0; li < N_PHASES; ++li) { a.ph_lo = li; a.ph_hi = li + 1; hipLaunchKernelGGL(mk_fwd, dim3(grid), dim3(512), LDS_BYTES, stream, a); }
#endif
}
```

```cpp
#include <hip/hip_runtime.h>
#include <cstdio>
#include <cstdint>

#ifndef MK_N_LAUNCHES
#define MK_N_LAUNCHES 1
#endif

#define LAS __attribute__((address_space(3)))
#define GAS __attribute__((address_space(1)))
typedef unsigned short bf16_t;
typedef short bf16x8 __attribute__((ext_vector_type(8)));
typedef short s16x4 __attribute__((ext_vector_type(4)));
typedef float f32x4 __attribute__((ext_vector_type(4)));
typedef float f32x2 __attribute__((ext_vector_type(2)));
typedef float f32x16 __attribute__((ext_vector_type(16)));
typedef unsigned u32x4 __attribute__((ext_vector_type(4)));
typedef int i32x4 __attribute__((ext_vector_type(4)));
typedef int i32x8 __attribute__((ext_vector_type(8)));
typedef unsigned u32x2 __attribute__((ext_vector_type(2)));
typedef __bf16 bf16x2_t __attribute__((ext_vector_type(2)));

constexpr int DM = 2048, NBATCH = 4, SEQ = 2048, MTOK = NBATCH * SEQ;
constexpr int NIN = 5120, PARTW = 1024, DFF = 5632, NUP = 2 * DFF, PLE = 256, NHEAD = 8;
constexpr float EPS = 1e-6f;
constexpr float LOG2E = 1.4426950408889634f;
constexpr float C2 = 0.125f * LOG2E;
constexpr float LAMBDA_INIT = 0.2f;

constexpr size_t MiB = 1u << 20;
constexpr size_t WS_CTL = 0, CTL_ZERO_BYTES = 64 * 1024;
constexpr size_t WS_ROPE = 1 * MiB;
constexpr size_t WS_LNST = 2 * MiB;
constexpr size_t WS_SSQ  = 3 * MiB;
constexpr size_t WS_WPUT = 4 * MiB;
constexpr size_t WS_PB   = 5 * MiB;
constexpr size_t WS_HALO = 9 * MiB;
constexpr size_t WS_WINT = 16 * MiB;
constexpr size_t WS_WOUTT = 36 * MiB;
constexpr size_t WS_WUPT = 44 * MiB;
constexpr size_t WS_WDT  = 88 * MiB;
constexpr size_t WS_WGT  = 110 * MiB;
constexpr size_t WS_A    = 118 * MiB;
constexpr size_t WS_H    = 150 * MiB;
constexpr size_t WS_UPB  = 182 * MiB;
constexpr size_t WS_QKVUG = 214 * MiB;
constexpr size_t PART_ELEMS = (size_t)MTOK * PARTW;
constexpr size_t WS_MIX  = 294 * MiB;
constexpr size_t WS_ACT  = 214 * MiB;
constexpr int    K8      = 2816;
constexpr size_t WS_A8   = 304 * MiB;
constexpr size_t WS_END  = 326 * MiB;
static_assert(WS_ACT + (size_t)MTOK * DFF * 2 <= WS_END && WS_MIX + (size_t)MTOK * DM * 2 <= WS_END, "ws map");

constexpr int CW_BAR = 1024;
constexpr int CW_PANEL = 8192;
constexpr int CW_QA = 4608, CW_QB = 5120, CW_DONE1 = 192, CW_DONE4 = 256;

constexpr int RING_BYTES = 131072;
constexpr int XLDS_OFF = RING_BYTES;
constexpr int LDS_BYTES = 147456;
constexpr int LDSCTL_OFF = LDS_BYTES - 512;
constexpr int CONV_LDS_PER_WAVE = 64 * 65 * 4;
static_assert(XLDS_OFF + 8192 <= LDSCTL_OFF && 8 * CONV_LDS_PER_WAVE <= LDSCTL_OFF, "lds map");

__device__ __forceinline__ unsigned f2bf(float f) { unsigned u = __builtin_bit_cast(unsigned, f); return (u + 0x7fffu + ((u >> 16) & 1u)) >> 16; }
__device__ __forceinline__ unsigned pk2(float lo, float hi) { f32x2 v = {lo, hi}; bf16x2_t b = __builtin_convertvector(v, bf16x2_t); return __builtin_bit_cast(unsigned, b); }
__device__ __forceinline__ float bf2f(unsigned short b) { return __builtin_bit_cast(float, (unsigned)b << 16); }
__device__ __forceinline__ float wave_sum(float v) {
#pragma unroll
    for (int o = 1; o < 64; o <<= 1) v += __shfl_xor(v, o);
    return v;
}
#define LDS_WAIT() asm volatile("s_waitcnt lgkmcnt(0)" ::: "memory")
#define VM_WAIT() asm volatile("s_waitcnt vmcnt(0)" ::: "memory")

__device__ __forceinline__ int fresh_lane() { int l; asm volatile("v_mbcnt_lo_u32_b32 %0, -1, 0\n\tv_mbcnt_hi_u32_b32 %0, -1, %0" : "=v"(l)); return l; }
namespace pg8 {
constexpr int BM = 256, BK = 64, HALF = 128, HTB = HALF * BK * 2, STAGE_BYTES = 8 * HTB, NXCD = 8, WGM = 8;
__host__ __device__ __forceinline__ int lds_byte(int r, int c) { const int st = (r >> 4) * 2 + (c >> 5), rr = r & 15, cc = c & 31, ob = rr * 64 + cc * 2; return st * 1024 + (ob ^ (((ob >> 9) & 1) << 5)); }
__host__ __device__ __forceinline__ void stage_rc(int b, int& R, int& C) { const int st = b / 1024, sb = b % 1024, swz = sb ^ (((sb >> 9) & 1) << 5); R = (st >> 1) * 16 + swz / 64; C = (st & 1) * 32 + (swz % 64) / 2; }
__host__ __device__ __forceinline__ int perm32(int rho) { const int n = rho >> 4, i = rho & 15; return 8 * (i >> 2) + 4 * n + (i & 3); }

struct Unit { int pm, pn; };
struct Gemm { const bf16_t* A; const bf16_t* Bt; int M, N, K; };

struct OneUnit {
    Unit u;
    __device__ __forceinline__ bool next(int i, Unit& o) const { if (i != 0) return false; o = u; return true; }
    __device__ __forceinline__ void a_ready(const Unit&) const {}
    __device__ __forceinline__ void done(const Unit&) const {}
};
struct StaticOrder {
    int nM, nN, nwg, G, c;
    __host__ __device__ void init(int M, int N, int G_, int c_) { nM = M / BM; nN = N / BM; nwg = nM * nN; G = G_; c = c_; }
    __host__ __device__ bool next(int i, Unit& u) const {
        const long L = (long)i * G + c; if (L >= nwg) return false;
        int wgid = (int)L; { const int q = nwg / NXCD, r = nwg % NXCD, xcd = wgid % NXCD, off = wgid / NXCD; wgid = (xcd < r ? xcd * (q + 1) : r * (q + 1) + (xcd - r) * q) + off; }
        const int nig = WGM * nN, gid = wgid / nig, fm = gid * WGM, gsz = (nM - fm) < WGM ? (nM - fm) : WGM;
        u.pm = fm + ((wgid % nig) % gsz); u.pn = (wgid % nig) / gsz; return true;
    }
    __device__ __forceinline__ void a_ready(const Unit&) const {}
    __device__ __forceinline__ void done(const Unit&) const {}
};

struct SmallOrder {
    int first, stride, count;
    __device__ __forceinline__ bool next(int i, Unit& u) const { if (i >= count) return false; const int v = first + i * stride; u.pm = v >> 3; u.pn = v & 7; return true; }
    __device__ __forceinline__ void a_ready(const Unit&) const {}
    __device__ __forceinline__ void done(const Unit&) const {}
};

__device__ __forceinline__ f32x2 gelu_pk(f32x2 v) {
    const f32x2 av = __builtin_elementwise_abs(v), d = av * 0.2316418882f + 1.0f;
    f32x2 t; t.x = __builtin_amdgcn_rcpf(d.x); t.y = __builtin_amdgcn_rcpf(d.y);
    f32x2 q = t * 0.5307027145f + (-0.7265760135f); q = q * t + 0.7107068705f; q = q * t + (-0.142248368f); q = q * t + 0.127414796f; q = q * t;
    const f32x2 s = (v * v) * (-0.72134752044f);
    f32x2 e; e.x = __builtin_amdgcn_exp2f(s.x); e.y = __builtin_amdgcn_exp2f(s.y);
    const f32x2 m = v * (q * e), r = v - m;
    f32x2 o; o.x = v.x < 0.f ? m.x : r.x; o.y = v.y < 0.f ? m.y : r.y; return o;
}
__device__ __forceinline__ f32x4 gelu4(f32x4 v) { const f32x2 a = gelu_pk((f32x2){v[0], v[1]}), b = gelu_pk((f32x2){v[2], v[3]}); return (f32x4){a.x, a.y, b.x, b.y}; }
__device__ __forceinline__ u32x4 pack8(f32x4 v0, f32x4 v1) { u32x4 w; w.x = pk2(v0[0], v0[1]); w.y = pk2(v0[2], v0[3]); w.z = pk2(v1[0], v1[1]); w.w = pk2(v1[2], v1[3]); return w; }
__device__ __forceinline__ float dot4(f32x4 a) { return (a[0] * a[0] + a[1] * a[1]) + (a[2] * a[2] + a[3] * a[3]); }
__device__ __forceinline__ float sum4(f32x4 a) { return (a[0] + a[1]) + (a[2] + a[3]); }
__device__ __forceinline__ f32x4 shfl_xor4(f32x4 v, int m) { return (f32x4){__shfl_xor(v[0], m), __shfl_xor(v[1], m), __shfl_xor(v[2], m), __shfl_xor(v[3], m)}; }


struct EpiIn {
    static constexpr bool PERM = true, AFTER_DRAIN = false; static constexpr int VM_MIN = 16;
    bf16_t* qkvug; const float* rope; float* lnstat;
    __device__ __forceinline__ void operator()(f32x4 (&acc)[2][2][4][2], const Unit& u, int wr, int wc, int fr, int fq) const {
        const int t = u.pn >> 2, colt = (u.pn & 3) * BM;
        bf16_t* base = qkvug + (size_t)t * PART_ELEMS;
        const int row0 = u.pm * BM + wr * 64 + fr, col0 = colt + wc * 32 + 8 * fq;
        if (t <= 1) {
            const float sc = (t == 0) ? C2 : 1.0f;
            const bool rotw = ((wc & 1) == 0);
            const float sgn = (fq == 0) ? -1.0f : 1.0f;
#pragma unroll
            for (int ai = 0; ai < 2; ++ai)
#pragma unroll
                for (int m = 0; m < 4; ++m) {
                    const int row = row0 + ai * HALF + m * 16;
                    f32x4 c0 = {1.f, 1.f, 1.f, 1.f}, c1 = c0, s0 = {0.f, 0.f, 0.f, 0.f}, s1 = s0;
                    if (rotw) { const float* rp = rope + (size_t)row * 16; c0 = *(const f32x4*)(rp); c1 = *(const f32x4*)(rp + 4); s0 = *(const f32x4*)(rp + 8); s1 = *(const f32x4*)(rp + 12); }
#pragma unroll
                    for (int bj = 0; bj < 2; ++bj) {
                        f32x4 v0 = acc[ai][bj][m][0], v1 = acc[ai][bj][m][1];
                        if (rotw) {
                            const f32x4 p0 = shfl_xor4(v0, 16), p1 = shfl_xor4(v1, 16);
                            const f32x4 r0 = v0 * c0 + (p0 * s0) * sgn, r1 = v1 * c1 + (p1 * s1) * sgn;
                            if (fq < 2) { v0 = r0; v1 = r1; }
                        }
                        v0 = v0 * sc; v1 = v1 * sc;
                        *(u32x4*)(base + (size_t)row * PARTW + col0 + bj * HALF) = pack8(v0, v1);
                    }
                }
        } else if (t == 2) {
#pragma unroll
            for (int ai = 0; ai < 2; ++ai)
#pragma unroll
                for (int m = 0; m < 4; ++m) {
                    const int row = row0 + ai * HALF + m * 16;
#pragma unroll
                    for (int bj = 0; bj < 2; ++bj) *(u32x4*)(base + (size_t)row * PARTW + col0 + bj * HALF) = pack8(acc[ai][bj][m][0], acc[ai][bj][m][1]);
                }
        } else {
#pragma unroll
            for (int ai = 0; ai < 2; ++ai)
#pragma unroll
                for (int m = 0; m < 4; ++m) {
                    const int row = row0 + ai * HALF + m * 16;
                    float s = 0.f, q = 0.f;
#pragma unroll
                    for (int bj = 0; bj < 2; ++bj) {
                        const f32x4 v0 = gelu4(acc[ai][bj][m][0]), v1 = gelu4(acc[ai][bj][m][1]);
                        s += sum4(v0) + sum4(v1); q += dot4(v0) + dot4(v1);
                        *(u32x4*)(base + (size_t)row * PARTW + col0 + bj * HALF) = pack8(v0, v1);
                    }
                    if (t == 4) {
                        s += __shfl_xor(s, 16); s += __shfl_xor(s, 32); q += __shfl_xor(q, 16); q += __shfl_xor(q, 32);
                        if (fq == 0) *(f32x2*)(lnstat + ((size_t)row * 16 + (u.pn & 3) * 4 + wc) * 2) = (f32x2){s, q};
                    }
                }
        }
    }
};

struct EpiBf16 {
    static constexpr bool PERM = true, AFTER_DRAIN = false; static constexpr int VM_MIN = 16;
    bf16_t* C; int ldc;
    __device__ __forceinline__ void operator()(f32x4 (&acc)[2][2][4][2], const Unit& u, int wr, int wc, int fr, int fq) const {
        const int row0 = u.pm * BM + wr * 64 + fr, col0 = u.pn * BM + wc * 32 + 8 * fq;
#pragma unroll
        for (int ai = 0; ai < 2; ++ai)
#pragma unroll
            for (int m = 0; m < 4; ++m) { bf16_t* rowp = C + (size_t)(row0 + ai * HALF + m * 16) * ldc + col0;
#pragma unroll
                for (int bj = 0; bj < 2; ++bj) *(u32x4*)(rowp + bj * HALF) = pack8(acc[ai][bj][m][0], acc[ai][bj][m][1]); }
    }
};
struct EpiF32 {
    static constexpr bool PERM = true, AFTER_DRAIN = false; static constexpr int VM_MIN = 32;
    float* C; int ldc;
    __device__ __forceinline__ void operator()(f32x4 (&acc)[2][2][4][2], const Unit& u, int wr, int wc, int fr, int fq) const {
        const int row0 = u.pm * BM + wr * 64 + fr, col0 = u.pn * BM + wc * 32 + 8 * fq;
#pragma unroll
        for (int ai = 0; ai < 2; ++ai)
#pragma unroll
            for (int m = 0; m < 4; ++m) { float* rowp = C + (size_t)(row0 + ai * HALF + m * 16) * ldc + col0;
#pragma unroll
                for (int bj = 0; bj < 2; ++bj) { *(f32x4*)(rowp + bj * HALF) = acc[ai][bj][m][0]; *(f32x4*)(rowp + bj * HALF + 4) = acc[ai][bj][m][1]; } }
    }
};

__device__ __forceinline__ void unpack8(u32x4 w, f32x4& a, f32x4& b) {
    a = (f32x4){__builtin_bit_cast(float, w.x << 16), __builtin_bit_cast(float, w.x & 0xffff0000u), __builtin_bit_cast(float, w.y << 16), __builtin_bit_cast(float, w.y & 0xffff0000u)};
    b = (f32x4){__builtin_bit_cast(float, w.z << 16), __builtin_bit_cast(float, w.z & 0xffff0000u), __builtin_bit_cast(float, w.w << 16), __builtin_bit_cast(float, w.w & 0xffff0000u)};
}
template <int MODE, bool F8COPY = false>
struct EpiResid {
    static constexpr bool PERM = true, AFTER_DRAIN = false; static constexpr int VM_MIN = 16;
    const void* base; bf16_t* out; float* ssq; const float* sd0; const float* gmix; unsigned char* h8 = nullptr;
    __device__ __forceinline__ void operator()(f32x4 (&acc)[2][2][4][2], const Unit& u, int wr, int wc, int fr, int fq) const {
        const int row0 = u.pm * BM + wr * 64 + fr, col0 = u.pn * BM + wc * 32 + 8 * fq;
        f32x4 gi[2][2];
        if (MODE == 2) {
#pragma unroll
            for (int bj = 0; bj < 2; ++bj)
#pragma unroll
                for (int n = 0; n < 2; ++n) { const f32x4 gq = *(const f32x4*)(gmix + col0 + bj * HALF + 4 * n);
#pragma unroll
                    for (int j = 0; j < 4; ++j) gi[bj][n][j] = (gq[j] != 0.f) ? __builtin_amdgcn_rcpf(gq[j]) : 0.f; }
        }
#pragma unroll
        for (int ai = 0; ai < 2; ++ai)
#pragma unroll
            for (int m = 0; m < 4; ++m) {
                const int row = row0 + ai * HALF + m * 16; float ss = 0.f;
                float sd = 1.f; if (MODE == 2) sd = sd0[row];
#pragma unroll
                for (int bj = 0; bj < 2; ++bj) {
                    const size_t off = (size_t)row * DM + col0 + bj * HALF;
                    f32x4 b0, b1;
                    if (MODE == 0) { b0 = *(const f32x4*)((const float*)base + off); b1 = *(const f32x4*)((const float*)base + off + 4); }
                    else { unpack8(*(const u32x4*)((const bf16_t*)base + off), b0, b1); if (MODE == 2) { b0 = b0 * sd * gi[bj][0]; b1 = b1 * sd * gi[bj][1]; } }
                    const f32x4 h0 = b0 + acc[ai][bj][m][0], h1 = b1 + acc[ai][bj][m][1];
                    ss += dot4(h0) + dot4(h1);
                    *(u32x4*)(out + off) = pack8(h0, h1);
                    if (F8COPY) { int w0 = 0, w1 = 0;
                        w0 = __builtin_amdgcn_cvt_pk_fp8_f32(h0[0], h0[1], w0, false); w0 = __builtin_amdgcn_cvt_pk_fp8_f32(h0[2], h0[3], w0, true);
                        w1 = __builtin_amdgcn_cvt_pk_fp8_f32(h1[0], h1[1], w1, false); w1 = __builtin_amdgcn_cvt_pk_fp8_f32(h1[2], h1[3], w1, true);
                        *(u32x2*)(h8 + off) = (u32x2){(unsigned)w0, (unsigned)w1}; }
                }
                ss += __shfl_xor(ss, 16); ss += __shfl_xor(ss, 32);
                if (fq == 0) unsafeAtomicAdd(ssq + row, ss);
            }
    }
};

template <bool FUSED>
struct EpiPle {
    static constexpr bool PERM = true, AFTER_DRAIN = false; static constexpr int VM_MIN = 16;
    const bf16_t* h; const bf16_t* upb; float* out; const float* ssq_in; float* ssq; unsigned* cnt; const float* gfin; float zscale = 1.0f;
    __device__ __forceinline__ void operator()(f32x4 (&acc)[2][2][4][2], const Unit& u, int wr, int wc, int fr, int fq) const {
        const int row0 = u.pm * BM + wr * 64 + fr, col0 = u.pn * BM + wc * 32 + 8 * fq;
#pragma unroll
        for (int ai = 0; ai < 2; ++ai)
#pragma unroll
            for (int m = 0; m < 4; ++m) {
                const int row = row0 + ai * HALF + m * 16; float ss = 0.f;
                const float rs = __builtin_amdgcn_rsqf(ssq_in[row] * (1.0f / DM) + EPS) * (-LOG2E) * zscale;
#pragma unroll
                for (int bj = 0; bj < 2; ++bj) {
                    const size_t off = (size_t)row * DM + col0 + bj * HALF;
                    f32x4 hb[2], ub[2]; unpack8(*(const u32x4*)(h + off), hb[0], hb[1]); unpack8(*(const u32x4*)(upb + off), ub[0], ub[1]);
#pragma unroll
                    for (int n = 0; n < 2; ++n) {
                        const f32x4 z = acc[ai][bj][m][n] * rs;
                        f32x4 gt;
#pragma unroll
                        for (int j = 0; j < 4; ++j) gt[j] = __builtin_amdgcn_rcpf(1.0f + __builtin_amdgcn_exp2f(z[j]));
                        const f32x4 h3 = hb[n] + ub[n] * gt;
                        if (FUSED) acc[ai][bj][m][n] = h3; else *(f32x4*)(out + off + 4 * n) = h3;
                        ss += dot4(h3);
                    }
                }
                ss += __shfl_xor(ss, 16); ss += __shfl_xor(ss, 32);
                if (fq == 0) unsafeAtomicAdd(ssq + row, ss);
                asm volatile("" ::: "memory");
            }
        if (FUSED) {
            asm volatile("s_waitcnt vmcnt(0)" ::: "memory");
            unsigned* pc = cnt + 64 * u.pm;
            if (fresh_lane() == 0) (void)__hip_atomic_fetch_add(pc, 1u, __ATOMIC_RELAXED, __HIP_MEMORY_SCOPE_AGENT);
            { unsigned sp = 0;
              while ((unsigned)__builtin_amdgcn_readfirstlane((int)__hip_atomic_load(pc, __ATOMIC_RELAXED, __HIP_MEMORY_SCOPE_AGENT)) < 64u) { __builtin_amdgcn_s_sleep(2); if (++sp > (1u << 20)) break; } }
            f32x4 gf[2][2];
#pragma unroll
            for (int bj = 0; bj < 2; ++bj)
#pragma unroll
                for (int n = 0; n < 2; ++n) gf[bj][n] = *(const f32x4*)(gfin + col0 + bj * HALF + 4 * n);
#pragma unroll
            for (int ai = 0; ai < 2; ++ai)
#pragma unroll
                for (int m = 0; m < 4; ++m) {
                    const int row = row0 + ai * HALF + m * 16;
                    float tot = 0.f; if (fq == 0) tot = unsafeAtomicAdd(ssq + row, 0.0f);
                    tot = __shfl(tot, fr);
                    const float rn = __builtin_amdgcn_rsqf(tot * (1.0f / DM) + EPS);
#pragma unroll
                    for (int bj = 0; bj < 2; ++bj)
#pragma unroll
                        for (int n = 0; n < 2; ++n) *(f32x4*)(out + (size_t)row * DM + col0 + bj * HALF + 4 * n) = acc[ai][bj][m][n] * rn * gf[bj][n];
                }
        }
    }
};

__device__ __forceinline__ float dpp_ror1(float v) { float r; asm volatile("s_nop 1\n\tv_mov_b32_dpp %0, %1 row_ror:1 row_mask:0xf bank_mask:0xf" : "=v"(r) : "v"(v)); return r; }
__device__ __forceinline__ float dpp_rol1(float v) { float r; asm volatile("s_nop 1\n\tv_mov_b32_dpp %0, %1 row_ror:15 row_mask:0xf bank_mask:0xf" : "=v"(r) : "v"(v)); return r; }
__device__ __forceinline__ f32x4 ror4(f32x4 v) { return (f32x4){dpp_ror1(v[0]), dpp_ror1(v[1]), dpp_ror1(v[2]), dpp_ror1(v[3])}; }
__device__ __forceinline__ f32x4 rol4(f32x4 v) { return (f32x4){dpp_rol1(v[0]), dpp_rol1(v[1]), dpp_rol1(v[2]), dpp_rol1(v[3])}; }
__device__ __forceinline__ void dpp_rot8(f32x4& pv, f32x4& nx, const f32x4& sp, const f32x4& sn) {
    float p0, p1, p2, p3, n0, n1, n2, n3;
    asm volatile("s_nop 1\n\t"
                 "v_mov_b32_dpp %0, %8 row_ror:1 row_mask:0xf bank_mask:0xf\n\t"
                 "v_mov_b32_dpp %1, %9 row_ror:1 row_mask:0xf bank_mask:0xf\n\t"
                 "v_mov_b32_dpp %2, %10 row_ror:1 row_mask:0xf bank_mask:0xf\n\t"
                 "v_mov_b32_dpp %3, %11 row_ror:1 row_mask:0xf bank_mask:0xf\n\t"
                 "v_mov_b32_dpp %4, %12 row_ror:15 row_mask:0xf bank_mask:0xf\n\t"
                 "v_mov_b32_dpp %5, %13 row_ror:15 row_mask:0xf bank_mask:0xf\n\t"
                 "v_mov_b32_dpp %6, %14 row_ror:15 row_mask:0xf bank_mask:0xf\n\t"
                 "v_mov_b32_dpp %7, %15 row_ror:15 row_mask:0xf bank_mask:0xf"
                 : "=&v"(p0), "=&v"(p1), "=&v"(p2), "=&v"(p3), "=&v"(n0), "=&v"(n1), "=&v"(n2), "=&v"(n3)
                 : "v"(sp[0]), "v"(sp[1]), "v"(sp[2]), "v"(sp[3]), "v"(sn[0]), "v"(sn[1]), "v"(sn[2]), "v"(sn[3]));
    pv = (f32x4){p0, p1, p2, p3}; nx = (f32x4){n0, n1, n2, n3};
}
__device__ __forceinline__ f32x4 fma4(f32x4 a, f32x4 b, f32x4 c) { return (f32x4){__builtin_fmaf(a[0], b[0], c[0]), __builtin_fmaf(a[1], b[1], c[1]), __builtin_fmaf(a[2], b[2], c[2]), __builtin_fmaf(a[3], b[3], c[3])}; }
struct EpiConvGlu {
    static constexpr bool PERM = true, AFTER_DRAIN = false; static constexpr int VM_MIN = 32;
    bf16_t* act; float* halo; const float* ssq_in; const float* cw; const float* cb; LAS unsigned char* xl; unsigned char* act8;
    __device__ __forceinline__ void operator()(f32x4 (&acc)[2][2][4][2], const Unit& u, int wr, int wc, int fr, int fq) const {
        const int row0 = u.pm * BM + wr * 64 + fr, cc0 = wc * 32 + 8 * fq;
#pragma unroll
        for (int ai = 0; ai < 2; ++ai)
#pragma unroll
            for (int m = 0; m < 4; ++m) {
                const float rs = __builtin_amdgcn_rsqf(ssq_in[row0 + ai * HALF + m * 16] * (1.0f / DM) + EPS);
#pragma unroll
                for (int bj = 0; bj < 2; ++bj)
#pragma unroll
                    for (int n = 0; n < 2; ++n) acc[ai][bj][m][n] = acc[ai][bj][m][n] * rs;
            }
#ifndef NO_CONV2
        LAS float* XF = (LAS float*)xl;
        LAS float* XL = (LAS float*)(xl + 4096);
#pragma unroll
        for (int ai = 0; ai < 2; ++ai) {
            const int run = ai * 2 + wr;
#pragma unroll
            for (int bj = 0; bj < 2; ++bj)
#pragma unroll
                for (int n = 0; n < 2; ++n) {
                    const int col = bj * HALF + cc0 + 4 * n;
                    if (fr == 0) *(LAS f32x4*)(XF + run * 256 + col) = acc[ai][bj][0][n];
                    if (fr == 15) *(LAS f32x4*)(XL + run * 256 + col) = acc[ai][bj][3][n];
                }
        }
        {
            float* hb = halo + (size_t)u.pm * 4 * NUP + (size_t)u.pn * BM;
            if (wr == 0 && fr < 2) {
#pragma unroll
                for (int bj = 0; bj < 2; ++bj)
#pragma unroll
                    for (int n = 0; n < 2; ++n) *(f32x4*)(hb + (size_t)fr * NUP + bj * HALF + cc0 + 4 * n) = acc[0][bj][0][n];
            }
            if (wr == 1 && fr >= 14) {
#pragma unroll
                for (int bj = 0; bj < 2; ++bj)
#pragma unroll
                    for (int n = 0; n < 2; ++n) *(f32x4*)(hb + (size_t)(fr - 12) * NUP + bj * HALF + cc0 + 4 * n) = acc[1][bj][3][n];
            }
        }
        asm volatile("s_waitcnt lgkmcnt(0)" ::: "memory"); __builtin_amdgcn_s_barrier(); asm volatile("" ::: "memory");
#else
        LAS float* XF = (LAS float*)xl; LAS float* XL = (LAS float*)(xl + 4096);
#endif
#ifndef NO_CONV3
        const int chbase = u.pn * HALF + cc0;
#pragma unroll
        for (int bj = 0; bj < 2; ++bj) {
#pragma unroll
            for (int n = 0; n < 2; ++n) {
                const int ch = bj * DFF + chbase + 4 * n, col = bj * HALF + cc0 + 4 * n;
                const f32x4 w0 = *(const f32x4*)(cw + ch), w1 = *(const f32x4*)(cw + NUP + ch), w2 = *(const f32x4*)(cw + 2 * NUP + ch), bb = *(const f32x4*)(cb + ch);
#pragma unroll
                for (int ai = 0; ai < 2; ++ai) {
                    const int run = ai * 2 + wr;
                    f32x4 hp = {0.f, 0.f, 0.f, 0.f}, hn = {0.f, 0.f, 0.f, 0.f};
                    if (run > 0) hp = *(const LAS f32x4*)(XL + (run - 1) * 256 + col);
                    if (run < 3) hn = *(const LAS f32x4*)(XF + (run + 1) * 256 + col);
                    f32x4 pv[4], nx[4];
#pragma unroll
                    for (int m = 0; m < 4; ++m) {
                        const f32x4 old = acc[ai][bj][m][n];
                        const f32x4 below = (m > 0) ? acc[ai][bj][m > 0 ? m - 1 : 0][n] : hp;
                        const f32x4 above = (m < 3) ? acc[ai][bj][m < 3 ? m + 1 : 3][n] : hn;
                        dpp_rot8(pv[m], nx[m], (fr == 15) ? below : old, (fr == 0) ? above : old);
                    }
#pragma unroll
                    for (int m = 0; m < 4; ++m) acc[ai][bj][m][n] = fma4(w2, nx[m], fma4(w1, acc[ai][bj][m][n], fma4(w0, pv[m], bb)));
                    asm volatile("" : "+v"(acc[ai][bj][0][n]), "+v"(acc[ai][bj][1][n]), "+v"(acc[ai][bj][2][n]), "+v"(acc[ai][bj][3][n]));
                    __builtin_amdgcn_sched_barrier(0);
                }
            }
        }
#else
        const int chbase = u.pn * HALF + cc0;
#endif
#pragma unroll
        for (int ai = 0; ai < 2; ++ai)
#pragma unroll
            for (int m = 0; m < 4; ++m) {
                const int row = row0 + ai * HALF + m * 16;
                f32x4 o[2];
#pragma unroll
                for (int n = 0; n < 2; ++n) { const f32x4 gq = acc[ai][0][m][n], uq = acc[ai][1][m][n];
#pragma unroll
                    for (int j = 0; j < 4; ++j) o[n][j] = gq[j] * __builtin_amdgcn_rcpf(1.0f + __builtin_amdgcn_exp2f(gq[j] * (-LOG2E))) * uq[j]; }
                if (u.pn * HALF < K8) { int w0 = 0, w1 = 0;
                    w0 = __builtin_amdgcn_cvt_pk_fp8_f32(o[0][0], o[0][1], w0, false); w0 = __builtin_amdgcn_cvt_pk_fp8_f32(o[0][2], o[0][3], w0, true);
                    w1 = __builtin_amdgcn_cvt_pk_fp8_f32(o[1][0], o[1][1], w1, false); w1 = __builtin_amdgcn_cvt_pk_fp8_f32(o[1][2], o[1][3], w1, true);
                    *(u32x2*)(act8 + (size_t)row * K8 + chbase) = (u32x2){(unsigned)w0, (unsigned)w1}; }
                else *(u32x4*)(act + (size_t)row * (DFF - K8) + (chbase - K8)) = pack8(o[0], o[1]);
            }
    }
};

template <class Epi, class Sched, bool ALIGN_EPI, bool SP2, bool PEEL, bool FP8, bool ZERO_IN>
__device__ __forceinline__ void gemm_phase_x(LAS unsigned char* lds, const Gemm g, const Sched& S, const Epi& E, f32x4 (&acc)[2][2][4][2], int wave_id, int tid_bias) {
    const int wid = wave_id + tid_bias, lane = fresh_lane(), tid = wid * 64 + lane, wr = wid >> 2, wc = wid & 3, fr = lane & 15, fq = lane >> 4;
    const int K = FP8 ? g.K / 2 : g.K, nt = K / BK;
    unsigned voffA[2], voffB[2];
#pragma unroll
    for (int i = 0; i < 2; ++i) { int R, C; stage_rc(tid * 16 + i * 8192, R, C); const int Rb = Epi::PERM ? ((R & ~31) + perm32(R & 31)) : R;
        voffA[i] = (unsigned)(R * K + C) * 2u; voffB[i] = (unsigned)(Rb * K + C) * 2u; }
    const int kstep = BK * 2;
    const int hstep = HALF * K * 2;
    const int tstep = 2 * hstep;
    const __amdgpu_buffer_rsrc_t rsA = __builtin_amdgcn_make_buffer_rsrc((void*)g.A, 0, 0x7fffffff, 0x00020000);
    const __amdgpu_buffer_rsrc_t rsB = __builtin_amdgcn_make_buffer_rsrc((void*)g.Bt, 0, 0x7fffffff, 0x00020000);
    const unsigned ldsw = (unsigned)wid * 1024u;
    const int aoff = lds_byte(wr * 64 + fr, fq * 8), boff = lds_byte(wc * 32 + fr, fq * 8);
#define PG8_SA(b, h) (((b) * 2 + (h)) * HTB)
#define PG8_SB(b, h) ((4 + (b) * 2 + (h)) * HTB)
#define PG8_STAGE(bufoff, rs, soff, voff) do { _Pragma("unroll") for (int _i = 0; _i < 2; ++_i) \
        __builtin_amdgcn_raw_ptr_buffer_load_lds(rs, (LAS unsigned*)(lds + (bufoff) + ldsw + _i * 8192), 16, (int)(voff)[_i], __builtin_amdgcn_readfirstlane(soff), 0, 0); } while (0)
#define PG8_LDA(dst, b, h) do { _Pragma("unroll") for (int m = 0; m < 4; ++m) _Pragma("unroll") for (int k = 0; k < 2; ++k) dst[m][k] = *(const LAS bf16x8*)(lds + PG8_SA(b, h) + aoff + m * 2048 + k * 1024); } while (0)
#define PG8_LDB(dst, b, h) do { _Pragma("unroll") for (int n = 0; n < 2; ++n) _Pragma("unroll") for (int k = 0; k < 2; ++k) dst[n][k] = *(const LAS bf16x8*)(lds + PG8_SB(b, h) + boff + n * 2048 + k * 1024); } while (0)
#define PG8_MMA(ai, bj, At, Bt) do { __builtin_amdgcn_s_setprio(1); _Pragma("unroll") for (int m = 0; m < 4; ++m) _Pragma("unroll") for (int n = 0; n < 2; ++n) { \
        if constexpr (FP8) { const i32x8 a8_ = __builtin_shufflevector(__builtin_bit_cast(i32x4, At[m][0]), __builtin_bit_cast(i32x4, At[m][1]), 0, 1, 2, 3, 4, 5, 6, 7); \
                             const i32x8 b8_ = __builtin_shufflevector(__builtin_bit_cast(i32x4, Bt[n][0]), __builtin_bit_cast(i32x4, Bt[n][1]), 0, 1, 2, 3, 4, 5, 6, 7); \
                             acc[ai][bj][m][n] = __builtin_amdgcn_mfma_scale_f32_16x16x128_f8f6f4(b8_, a8_, acc[ai][bj][m][n], 0, 0, 0, 0x7f7f7f7f, 0, 0x7f7f7f7f); } \
        else { _Pragma("unroll") for (int k = 0; k < 2; ++k) acc[ai][bj][m][n] = __builtin_amdgcn_mfma_f32_16x16x32_bf16(Bt[n][k], At[m][k], acc[ai][bj][m][n], 0, 0, 0); } } \
        __builtin_amdgcn_s_setprio(0); } while (0)
#define PG8_WAIT_V(n) asm volatile("s_waitcnt vmcnt(" #n ")" ::: "memory")
#define PG8_WAIT_L(n) asm volatile("s_waitcnt lgkmcnt(" #n ")" ::: "memory")
#define PG8_BAR __builtin_amdgcn_s_barrier()
#define PG8_SCHED __builtin_amdgcn_sched_barrier(0)
    Unit cur, nxt; int ui = 0;
    if (!S.next(0, cur)) return;
    if (ZERO_IN) {
#pragma unroll
    for (int a = 0; a < 2; ++a)
#pragma unroll
        for (int b = 0; b < 2; ++b)
#pragma unroll
            for (int m = 0; m < 4; ++m)
#pragma unroll
                for (int n = 0; n < 2; ++n) acc[a][b][m][n] = (f32x4){0.f, 0.f, 0.f, 0.f};
    }
    bf16x8 At[4][2], B0[2][2], B1[2][2];
    int cA = cur.pm * tstep, cB = cur.pn * tstep;
    S.a_ready(cur);
    if constexpr (SP2) {
        PG8_STAGE(PG8_SB(0, 0), rsB, cB, voffB); PG8_STAGE(PG8_SB(0, 1), rsB, cB + hstep, voffB); PG8_STAGE(PG8_SA(0, 0), rsA, cA, voffA); PG8_STAGE(PG8_SA(0, 1), rsA, cA + hstep, voffA);
        if (wr == 1) PG8_BAR;
        PG8_WAIT_V(2); PG8_BAR;
        PG8_STAGE(PG8_SB(1, 0), rsB, cB + kstep, voffB); PG8_STAGE(PG8_SA(1, 0), rsA, cA + kstep, voffA); PG8_STAGE(PG8_SB(1, 1), rsB, cB + hstep + kstep, voffB);
        PG8_WAIT_V(6); PG8_BAR;
    } else {
        PG8_STAGE(PG8_SB(0, 0), rsB, cB, voffB); PG8_STAGE(PG8_SA(0, 0), rsA, cA, voffA); PG8_STAGE(PG8_SB(0, 1), rsB, cB + hstep, voffB); PG8_STAGE(PG8_SA(0, 1), rsA, cA + hstep, voffA);
        if (wr == 1) PG8_BAR;
        PG8_WAIT_V(4); PG8_BAR;
        PG8_STAGE(PG8_SB(1, 0), rsB, cB + kstep, voffB); PG8_STAGE(PG8_SA(1, 0), rsA, cA + kstep, voffA); PG8_STAGE(PG8_SB(1, 1), rsB, cB + hstep + kstep, voffB);
        PG8_WAIT_V(6); PG8_BAR;
    }
    for (;;) {
        const bool has_next = S.next(ui + 1, nxt);
        const int nA = has_next ? nxt.pm * tstep : cA, nB = has_next ? nxt.pn * tstep : cB;
#define PG8_ITER(WV12, WV3, SA11) do { \
            const bool last = (t == nt - 2); \
            const int a1 = cA + (t + 1) * kstep; \
            const int a2 = last ? nA : cA + (t + 2) * kstep, b2 = last ? nB : cB + (t + 2) * kstep; \
            const int a3 = a2 + kstep, b3 = b2 + kstep; \
            if (last && has_next) S.a_ready(nxt); \
            if constexpr (SP2) { \
            PG8_LDB(B0, 0, 0); PG8_LDB(B1, 0, 1); PG8_SCHED; PG8_LDA(At, 0, 0); if (SA11) PG8_STAGE(PG8_SA(1, 1), rsA, a1 + hstep, voffA); \
            WV12; PG8_WAIT_L(0); PG8_BAR; PG8_MMA(0, 0, At, B0); PG8_MMA(0, 1, At, B1); PG8_BAR; PG8_SCHED; \
            PG8_LDA(At, 0, 1); PG8_STAGE(PG8_SB(0, 0), rsB, b2, voffB); PG8_STAGE(PG8_SB(0, 1), rsB, b2 + hstep, voffB); PG8_STAGE(PG8_SA(0, 0), rsA, a2, voffA); \
            WV12; PG8_WAIT_L(0); PG8_BAR; PG8_MMA(1, 0, At, B0); PG8_MMA(1, 1, At, B1); PG8_BAR; PG8_SCHED; \
            PG8_LDB(B0, 1, 0); PG8_LDB(B1, 1, 1); PG8_SCHED; PG8_LDA(At, 1, 0); PG8_STAGE(PG8_SA(0, 1), rsA, a2 + hstep, voffA); \
            WV3; PG8_WAIT_L(0); PG8_BAR; PG8_MMA(0, 0, At, B0); PG8_MMA(0, 1, At, B1); PG8_BAR; PG8_SCHED; \
            PG8_LDA(At, 1, 1); PG8_STAGE(PG8_SB(1, 0), rsB, b3, voffB); PG8_STAGE(PG8_SB(1, 1), rsB, b3 + hstep, voffB); PG8_STAGE(PG8_SA(1, 0), rsA, a3, voffA); \
            PG8_WAIT_V(8); PG8_WAIT_L(0); PG8_BAR; PG8_MMA(1, 0, At, B0); PG8_MMA(1, 1, At, B1); PG8_BAR; PG8_SCHED; \
            if (PEEL && last && has_next) PG8_STAGE(PG8_SA(1, 1), rsA, a3 + hstep, voffA); \
            } else { \
            PG8_LDB(B0, 0, 0); PG8_SCHED; PG8_LDA(At, 0, 0); PG8_STAGE(PG8_SA(1, 1), rsA, a1 + hstep, voffA); \
            PG8_WAIT_L(8); PG8_BAR; PG8_WAIT_L(0); PG8_MMA(0, 0, At, B0); PG8_BAR; PG8_SCHED; \
            PG8_LDB(B1, 0, 1); PG8_STAGE(PG8_SB(0, 0), rsB, b2, voffB); \
            PG8_BAR; PG8_WAIT_L(0); PG8_MMA(0, 1, At, B1); PG8_BAR; \
            PG8_LDA(At, 0, 1); PG8_STAGE(PG8_SA(0, 0), rsA, a2, voffA); \
            PG8_BAR; PG8_WAIT_L(0); PG8_MMA(1, 0, At, B0); PG8_BAR; PG8_SCHED; \
            PG8_STAGE(PG8_SB(0, 1), rsB, b2 + hstep, voffB); \
            PG8_WAIT_V(6); PG8_BAR; PG8_MMA(1, 1, At, B1); PG8_BAR; \
            PG8_LDB(B0, 1, 0); PG8_SCHED; PG8_LDA(At, 1, 0); PG8_STAGE(PG8_SA(0, 1), rsA, a2 + hstep, voffA); \
            PG8_WAIT_L(8); PG8_BAR; PG8_WAIT_L(0); PG8_MMA(0, 0, At, B0); PG8_BAR; PG8_SCHED; \
            PG8_LDB(B1, 1, 1); PG8_STAGE(PG8_SB(1, 0), rsB, b3, voffB); \
            PG8_BAR; PG8_WAIT_L(0); PG8_MMA(0, 1, At, B1); PG8_BAR; \
            PG8_LDA(At, 1, 1); PG8_STAGE(PG8_SA(1, 0), rsA, a3, voffA); \
            PG8_BAR; PG8_WAIT_L(0); PG8_MMA(1, 0, At, B0); PG8_BAR; PG8_SCHED; \
            PG8_STAGE(PG8_SB(1, 1), rsB, b3 + hstep, voffB); \
            PG8_WAIT_V(6); PG8_BAR; PG8_MMA(1, 1, At, B1); PG8_BAR; \
            } \
        } while (0)
        int t = 0;
        if (SP2 && PEEL && ui > 0) { PG8_ITER(asm volatile("s_waitcnt vmcnt(%0)" :: "n"(8 + Epi::VM_MIN) : "memory"), asm volatile("s_waitcnt vmcnt(%0)" :: "n"(8 + Epi::VM_MIN) : "memory"), false); t = 2; }
        for (; t < nt; t += 2) PG8_ITER(PG8_WAIT_V(8), PG8_WAIT_V(8), true);
#undef PG8_ITER
        if constexpr (ALIGN_EPI) { if (wr == 0) PG8_BAR; }
        if constexpr (!Epi::AFTER_DRAIN) { const int l2 = fresh_lane(); E(acc, cur, wr, wc, l2 & 15, l2 >> 4); S.done(cur); }
        if (!has_next) break;
#pragma unroll
        for (int a = 0; a < 2; ++a)
#pragma unroll
            for (int b = 0; b < 2; ++b)
#pragma unroll
                for (int m = 0; m < 4; ++m)
#pragma unroll
                    for (int n = 0; n < 2; ++n) acc[a][b][m][n] = (f32x4){0.f, 0.f, 0.f, 0.f};
        cur = nxt; cA = nA; cB = nB; ++ui;
        if constexpr (ALIGN_EPI) { if (wr == 1) PG8_BAR; }
    }
    PG8_WAIT_V(0);
    if constexpr (!ALIGN_EPI) { if (wr == 0) PG8_BAR; }
    PG8_BAR;
#undef PG8_SA
#undef PG8_SB
#undef PG8_STAGE
#undef PG8_LDA
#undef PG8_LDB
#undef PG8_MMA
#undef PG8_WAIT_V
#undef PG8_WAIT_L
#undef PG8_BAR
#undef PG8_SCHED
}
template <class Epi, class Sched, bool ALIGN_EPI = false, bool SP2 = false, bool PEEL = false, bool FP8 = false>
__device__ __forceinline__ void gemm_phase(LAS unsigned char* lds, const Gemm g, const Sched& S, const Epi& E, int wave_id, int tid_bias = 0) {
    f32x4 acc[2][2][4][2];
    gemm_phase_x<Epi, Sched, ALIGN_EPI, SP2, PEEL, FP8, true>(lds, g, S, E, acc, wave_id, tid_bias);
}
struct EpiScale {
    static constexpr bool PERM = true, AFTER_DRAIN = false; static constexpr int VM_MIN = 0;
    float sc;
    __device__ __forceinline__ void operator()(f32x4 (&acc)[2][2][4][2], const Unit&, int, int, int, int) const {
#pragma unroll
        for (int a = 0; a < 2; ++a)
#pragma unroll
            for (int b = 0; b < 2; ++b)
#pragma unroll
                for (int m = 0; m < 4; ++m)
#pragma unroll
                    for (int n = 0; n < 2; ++n) acc[a][b][m][n] = acc[a][b][m][n] * sc;
    }
};
}

#define XB_TMO      128
#define XB_XCNT(j)  (256  + 64 * (j))
#define XB_XSUB(j)  (1280 + 64 * (j))
#define XB_XGEN(j)  (2304 + 64 * (j))
#define XB_TOP      3328
#define XB_TOPGEN   3392
#define XCD_BAR_WORDS 3456
#define XB_SPIN_CAP (1u << 18)
__device__ __forceinline__ unsigned xb_ld(unsigned* p)              { return __hip_atomic_load(p, __ATOMIC_RELAXED, __HIP_MEMORY_SCOPE_AGENT); }
__device__ __forceinline__ unsigned xb_add(unsigned* p, unsigned v) { return __hip_atomic_fetch_add(p, v, __ATOMIC_RELAXED, __HIP_MEMORY_SCOPE_AGENT); }
__device__ __forceinline__ unsigned xb_xcc_id() { return (unsigned)__builtin_amdgcn_s_getreg((3 << 11) | 20) & 0xFu; }
#define XB_SPIN(cond, bar) do { unsigned _sp = 0; while (cond) { __builtin_amdgcn_s_sleep(1); \
    if ((++_sp & 255u) == 0u) { if (xb_ld(&(bar)[XB_TMO])) break; if (_sp > XB_SPIN_CAP) { atomicAdd(&(bar)[XB_TMO], 1u); break; } } } } while (0)
struct XcdBarrier { unsigned* bar; unsigned x; volatile LAS unsigned* st; int wave; };
__device__ __forceinline__ XcdBarrier xcd_barrier_post(unsigned* bar, volatile LAS unsigned* st) {
    XcdBarrier b; b.bar = bar; b.x = xb_xcc_id(); b.st = st; b.wave = __builtin_amdgcn_readfirstlane((int)(threadIdx.x >> 6));
    if (threadIdx.x == 0) (void)xb_add(&bar[XB_XCNT(b.x)], 1u);
    return b;
}
__device__ __forceinline__ void xcd_barrier_complete(unsigned* bar, unsigned x, unsigned& nloc, unsigned& nx) {
    const unsigned G = gridDim.x * gridDim.y * gridDim.z;
    unsigned sum, cnt, mine, sp = 0u;
    for (;;) {
        sum = 0u; cnt = 0u; mine = 0u;
#pragma unroll
        for (unsigned j = 0; j < 16; ++j) { const unsigned c = xb_ld(&bar[XB_XCNT(j)]); sum += c; cnt += (c > 0u) ? 1u : 0u; mine = (j == x) ? c : mine; }
        if (sum == G) break;
        __builtin_amdgcn_s_sleep(1);
        if ((++sp & 255u) == 0u) { if (xb_ld(&bar[XB_TMO])) break; if (sp > XB_SPIN_CAP) { atomicAdd(&bar[XB_TMO], 1u); break; } }
    }
    nloc = mine > 0u ? mine : 1u; nx = cnt > 0u ? cnt : 1u;
}
__device__ __forceinline__ void xcd_barrier(const XcdBarrier& b) {
    asm volatile("s_waitcnt vmcnt(0)" ::: "memory");
    __syncthreads();
    if (b.wave == 0 && fresh_lane() == 0) {
        unsigned* bar = b.bar;
        __builtin_amdgcn_s_waitcnt(0);
        unsigned nloc = b.st[0], nx = b.st[1];
        if (nloc == 0u) { xcd_barrier_complete(bar, b.x, nloc, nx); b.st[0] = nloc; b.st[1] = nx; }
        const unsigned old = xb_add(&bar[XB_XSUB(b.x)], 1u);
        const unsigned gen = old / nloc;
        if (old + 1u == (gen + 1u) * nloc) {
            __builtin_amdgcn_fence(__ATOMIC_RELEASE, "agent");
            asm volatile("s_waitcnt vmcnt(0)" ::: "memory");
            const unsigned og = xb_add(&bar[XB_TOP], 1u);
            const unsigned tg = og / nx;
            if (og + 1u == (tg + 1u) * nx) xb_add(&bar[XB_TOPGEN], 1u);
            else XB_SPIN(xb_ld(&bar[XB_TOPGEN]) == tg, bar);
            __builtin_amdgcn_fence(__ATOMIC_ACQUIRE, "agent");
            xb_add(&bar[XB_XGEN(b.x)], 1u);
            asm volatile("s_waitcnt vmcnt(0)" ::: "memory");
        } else {
            XB_SPIN(xb_ld(&bar[XB_XGEN(b.x)]) == gen, bar);
            __builtin_amdgcn_fence(__ATOMIC_ACQUIRE, "agent");
            asm volatile("s_waitcnt vmcnt(0)" ::: "memory");
        }
    }
    __syncthreads();
}

struct Frame {
    LAS unsigned char* lds;
    int tid, lane, wave, vcu, G;
    const float *x, *p; const int* pos;
    const float *g_mix, *w_in, *lq1, *lk1, *lq2, *lk2, *g_subln, *ln_g, *ln_b, *w_sp, *b_sp, *w_out, *g_ffn, *w_up, *conv_w, *conv_b, *w_down, *g_ple, *w_gate, *w_pup, *g_final;
    float* out; unsigned char* ws;
};

__device__ __forceinline__ void conv_load(const float* W, int N, int item, int lane, f32x4 (&v)[16]) {
    const int nblk = N / 64, kb = item / nblk, nb = item % nblk, k0 = 64 * kb, n0 = 64 * nb;
    const int lr = lane >> 4, lc = (lane & 15) * 4;
    const float* src = W + (size_t)(k0 + lr) * N + n0 + lc;
#pragma unroll
    for (int i = 0; i < 16; ++i) v[i] = __builtin_nontemporal_load((const f32x4*)(src + (size_t)(4 * i) * N));
}
constexpr float W8_SCALE = 64.0f;
template <int MODE>
__device__ __forceinline__ void conv_store(f32x4 (&v)[16], int K, int N, bf16_t* WT, LAS float* scr, int item, int lane, const float* gk = nullptr) {
    const int nblk = N / 64, kb = item / nblk, nb = item % nblk, k0 = 64 * kb, n0 = 64 * nb;
    const int lr = lane >> 4, lc = (lane & 15) * 4;
#pragma unroll
    for (int i = 0; i < 16; ++i) { if (gk) v[i] = v[i] * (gk[k0 + 4 * i + lr] * (MODE == 2 ? W8_SCALE : 1.0f)); else if (MODE == 2) v[i] = v[i] * W8_SCALE;
        LAS float* d = scr + (4 * i + lr) * 65 + lc; d[0] = v[i][0]; d[1] = v[i][1]; d[2] = v[i][2]; d[3] = v[i][3]; }
    LDS_WAIT(); asm volatile("" ::: "memory");
    int r0 = n0;
    if (MODE == 1) { const int isu = n0 >= DFF ? 1 : 0, ch = n0 - isu * DFF; r0 = (ch >> 7) * 256 + isu * 128 + (ch & 127); }
    const int c = lane & 7;
#pragma unroll
    for (int j = 0; j < 8; ++j) { const int n = (lane >> 3) + 8 * j; const LAS float* sp = scr + (8 * c) * 65 + n;
        if (MODE == 2) { int w0 = 0, w1 = 0;
            w0 = __builtin_amdgcn_cvt_pk_fp8_f32(sp[0], sp[65], w0, false); w0 = __builtin_amdgcn_cvt_pk_fp8_f32(sp[2 * 65], sp[3 * 65], w0, true);
            w1 = __builtin_amdgcn_cvt_pk_fp8_f32(sp[4 * 65], sp[5 * 65], w1, false); w1 = __builtin_amdgcn_cvt_pk_fp8_f32(sp[6 * 65], sp[7 * 65], w1, true);
            *(u32x2*)((unsigned char*)WT + (size_t)(r0 + n) * K + k0 + 8 * c) = (u32x2){(unsigned)w0, (unsigned)w1}; }
        else {
        u32x4 o; o.x = pk2(sp[0], sp[65]); o.y = pk2(sp[2 * 65], sp[3 * 65]); o.z = pk2(sp[4 * 65], sp[5 * 65]); o.w = pk2(sp[6 * 65], sp[7 * 65]);
        *(u32x4*)(WT + (size_t)(r0 + n) * K + k0 + 8 * c) = o; } }
    LDS_WAIT(); asm volatile("" ::: "memory");
}
template <int MODE>
__device__ __forceinline__ void conv_item(const float* W, int K, int N, bf16_t* WT, LAS float* scr, int item, int lane, const float* gk = nullptr) {
    f32x4 v[16]; conv_load(W, N, item, lane, v); conv_store<MODE>(v, K, N, WT, scr, item, lane, gk);
}
template <int MODE>
__device__ __forceinline__ void conv_pair(const float* W, int K, int N, bf16_t* WT, LAS float* scr, int item, int lane, const float* gk = nullptr) {
    f32x4 va[16], vb[16]; conv_load(W, N, item, lane, va); conv_load(W, N, item + 1, lane, vb);
    conv_store<MODE>(va, K, N, WT, scr, item, lane, gk); conv_store<MODE>(vb, K, N, WT, scr, item + 1, lane, gk);
}
constexpr int IT_OUT = (DM / 64) * (DM / 64), IT_UP = (DM / 64) * (NUP / 64), IT_DN = (DFF / 64) * (DM / 64), IT_G = IT_OUT;
constexpr int SEG_A_ITEMS = IT_OUT + IT_UP, SEG_B_ITEMS = IT_DN + IT_G;
__device__ __forceinline__ unsigned q_ld(unsigned* p) { return __hip_atomic_load(p, __ATOMIC_RELAXED, __HIP_MEMORY_SCOPE_AGENT); }
__device__ __forceinline__ unsigned q_add(unsigned* p, unsigned v) { return __hip_atomic_fetch_add(p, v, __ATOMIC_RELAXED, __HIP_MEMORY_SCOPE_AGENT); }
__device__ __forceinline__ void conv_drain(Frame& F, int seg, unsigned done_target) {
    LAS float* scr = (LAS float*)(F.lds + F.wave * CONV_LDS_PER_WAVE);
    unsigned char* ws = F.ws; unsigned* ctl = (unsigned*)(ws + WS_CTL);
    unsigned* q = ctl + (seg ? CW_QB : CW_QA); unsigned* dn = ctl + (seg ? CW_DONE4 : CW_DONE1);
    const int nit = seg ? SEG_B_ITEMS : SEG_A_ITEMS, per = nit / 8;
    const int home = (int)(blockIdx.x & 7);
    for (int ss = 0; ss < 8; ++ss) {
        const int sh = (home + ss) & 7; unsigned* qh = q + 64 * sh;
        for (;;) {
            if (done_target) { if ((unsigned)__builtin_amdgcn_readfirstlane((int)q_ld(dn)) >= done_target) return; }
            if ((int)__builtin_amdgcn_readfirstlane((int)q_ld(qh)) >= per) break;
            unsigned i0 = 0; if (F.lane == 0) i0 = q_add(qh, 2u);
            i0 = (unsigned)__builtin_amdgcn_readfirstlane((int)i0);
            if ((int)i0 >= per) break;
            { const int it = sh * per + (int)i0;
                if (seg == 0) { if (it < IT_OUT) conv_pair<0>(F.w_out, DM, DM, (bf16_t*)(ws + WS_WOUTT), scr, it, F.lane); else conv_pair<1>(F.w_up, DM, NUP, (bf16_t*)(ws + WS_WUPT), scr, it - IT_OUT, F.lane, F.g_ffn); }
                else { if (it < IT_DN) { if (it < (K8 / 64) * (DM / 64)) conv_pair<2>(F.w_down, K8, DM, (bf16_t*)(ws + WS_WDT), scr, it, F.lane);
                                        else conv_pair<0>(F.w_down, DFF - K8, DM, (bf16_t*)(ws + WS_WDT + (size_t)DM * K8) - K8, scr, it, F.lane); }
                       else conv_pair<2>(F.w_gate, DM, DM, (bf16_t*)(ws + WS_WGT), scr, it - IT_DN, F.lane, F.g_ple); } }
        }
    }
}
static_assert(SEG_A_ITEMS % 16 == 0 && SEG_B_ITEMS % 16 == 0 && IT_OUT % 2 == 0 && IT_DN % 2 == 0, "queue shards / item pairs");
__device__ __forceinline__ void p0_prologue(Frame& F) {
    LAS float* scr = (LAS float*)(F.lds + F.wave * CONV_LDS_PER_WAVE);
    const int gw = F.vcu * 8 + F.wave, NGW = F.G * 8;
    unsigned char* ws = F.ws;
    constexpr int I_IN = (DM / 64) * (NIN / 64), I_PU = (PLE / 64) * (DM / 64);
    for (int it = gw; it < I_IN + I_PU; it += 2 * NGW) {
        const int it2 = it + NGW; const bool two = it2 < I_IN + I_PU;
        f32x4 va[16], vb[16];
        if (it < I_IN) conv_load(F.w_in, NIN, it, F.lane, va); else conv_load(F.w_pup, DM, it - I_IN, F.lane, va);
        if (two) { if (it2 < I_IN) conv_load(F.w_in, NIN, it2, F.lane, vb); else conv_load(F.w_pup, DM, it2 - I_IN, F.lane, vb); }
        if (it < I_IN) conv_store<0>(va, DM, NIN, (bf16_t*)(ws + WS_WINT), scr, it, F.lane); else conv_store<0>(va, PLE, DM, (bf16_t*)(ws + WS_WPUT), scr, it - I_IN, F.lane);
        if (two) { if (it2 < I_IN) conv_store<0>(vb, DM, NIN, (bf16_t*)(ws + WS_WINT), scr, it2, F.lane); else conv_store<0>(vb, PLE, DM, (bf16_t*)(ws + WS_WPUT), scr, it2 - I_IN, F.lane); }
    }
    bf16_t* A0 = (bf16_t*)(ws + WS_A);
    {
        f32x4 v[8], nv[8];
        int m = gw;
        if (m < MTOK) { const f32x4* xr = (const f32x4*)(F.x + (size_t)m * DM) + F.lane;
#pragma unroll
            for (int j = 0; j < 8; ++j) nv[j] = __builtin_nontemporal_load(xr + 64 * j); }
        for (; m < MTOK; m += NGW) {
#pragma unroll
            for (int j = 0; j < 8; ++j) v[j] = nv[j];
            if (m + NGW < MTOK) { const f32x4* xr = (const f32x4*)(F.x + (size_t)(m + NGW) * DM) + F.lane;
#pragma unroll
                for (int j = 0; j < 8; ++j) nv[j] = __builtin_nontemporal_load(xr + 64 * j); }
            float s = 0.f;
#pragma unroll
            for (int j = 0; j < 8; ++j) s += pg8::dot4(v[j]);
            const float sd = sqrtf(wave_sum(s) * (1.0f / DM) + EPS), rstd = 1.0f / sd;
            if (F.lane == 0) ((float*)(ws + WS_SSQ))[3 * MTOK + m] = sd;
            u32x2* o8 = (u32x2*)(A0 + (size_t)m * DM) + F.lane;
#pragma unroll
            for (int j = 0; j < 8; ++j) { const f32x4 gq = *((const f32x4*)F.g_mix + F.lane + 64 * j); const f32x4 y = v[j] * rstd * gq; u32x2 w; w.x = pk2(y[0], y[1]); w.y = pk2(y[2], y[3]); o8[64 * j] = w; }
        }
    }
    {
        const int gt = F.vcu * 512 + F.tid, NGT = F.G * 512;
        bf16_t* PB = (bf16_t*)(ws + WS_PB);
        for (int i = gt; i < MTOK * PLE / 4; i += NGT) { const f32x4 v = __builtin_nontemporal_load((const f32x4*)F.p + i); u32x2 w; w.x = pk2(v[0], v[1]); w.y = pk2(v[2], v[3]); *((u32x2*)PB + i) = w; }
        float* rope = (float*)(ws + WS_ROPE);
        for (int i = gt; i < MTOK * 8; i += NGT) {
            const int row = i >> 3, fi = i & 7;
            const float invf = (float)exp2(-(double)fi * (18.931568569324174 / 8.0));
            const float ang = (float)F.pos[row] * invf;
            const double a = (double)ang, kq = rint(a * 0.63661977236758134);
            const double r = fma(-kq, 1.5707963267948966, a) - kq * 6.123233995736766e-17;
            const double r2 = r * r;
            const double sn = r + r * r2 * (-1.0 / 6 + r2 * (1.0 / 120 + r2 * (-1.0 / 5040 + r2 * (1.0 / 362880 + r2 * (-1.0 / 39916800)))));
            const double cs = 1.0 + r2 * (-0.5 + r2 * (1.0 / 24 + r2 * (-1.0 / 720 + r2 * (1.0 / 40320 + r2 * (-1.0 / 3628800 + r2 * (1.0 / 479001600))))));
            const int qd = ((int)kq) & 3;
            const double sv = (qd == 0) ? sn : (qd == 1) ? cs : (qd == 2) ? -sn : -cs;
            const double cv = (qd == 0) ? cs : (qd == 1) ? -sn : (qd == 2) ? -cs : sn;
            rope[(size_t)row * 16 + fi] = (float)cv; rope[(size_t)row * 16 + 8 + fi] = (float)sv;
        }
        float* ssq = (float*)(ws + WS_SSQ);
        for (int i = gt; i < 3 * MTOK; i += NGT) ssq[i] = 0.f;
    }
}

__device__ __forceinline__ int crow(int r, int hi) { return (r & 3) + 8 * (r >> 2) + 4 * hi; }
__device__ __forceinline__ s16x4 vtr(const LAS unsigned char* p) { typedef short v4i16_t __attribute__((ext_vector_type(4))); return __builtin_bit_cast(s16x4, __builtin_amdgcn_ds_read_tr16_b64_v4i16((LAS v4i16_t*)p)); }
#define MF32(a, b, c) __builtin_amdgcn_mfma_f32_32x32x16_bf16((a), (b), (c), 0, 0, 0)
__device__ __forceinline__ void glds16(const void* gsrc, unsigned lds_dst) { unsigned keep;
    asm volatile("s_mov_b32 %0, m0\n\ts_mov_b32 m0, %2\n\ts_nop 0\n\tglobal_load_lds_dwordx4 %1, off\n\ts_mov_b32 m0, %0" : "=&s"(keep) : "v"(gsrc), "s"(lds_dst) : "memory"); }
constexpr float ATT_THR = 8.0f;
__device__ __forceinline__ float rowmax32(const f32x16& a, const f32x16& b) {
    float x = fmaxf(fmaxf(a[0], a[1]), a[2]), y = fmaxf(fmaxf(b[0], b[1]), b[2]);
#pragma unroll
    for (int r = 3; r < 15; r += 2) { x = fmaxf(fmaxf(x, a[r]), a[r + 1]); y = fmaxf(fmaxf(y, b[r]), b[r + 1]); }
    x = fmaxf(fmaxf(x, a[15]), fmaxf(y, b[15]));
    return fmaxf(x, __shfl_xor(x, 32));
}
__device__ __forceinline__ void att_qk(f32x16& n0, f32x16& n1, const LAS unsigned char* kb, const bf16x8 (&qr)[4]) {
    n0 = (f32x16){}; n1 = (f32x16){};
#pragma unroll
    for (int d0 = 0; d0 < 4; ++d0) {
        const bf16x8 a0 = *(const LAS bf16x8*)(kb + d0 * 2048), a1 = *(const LAS bf16x8*)(kb + d0 * 2048 + 512);
        n0 = MF32(a0, qr[d0], n0); n1 = MF32(a1, qr[d0], n1); }
}
__device__ __forceinline__ float fadd_s(float a, float b) { float r; asm("v_add_f32_e32 %0, %1, %2" : "=v"(r) : "v"(a), "v"(b)); return r; }
__device__ __forceinline__ float fmax3_s(float a, float b, float c) { float r; asm("v_max3_f32 %0, %1, %2, %3" : "=v"(r) : "v"(a), "v"(b), "v"(c)); return r; }
__device__ __forceinline__ float fmax_s(float a, float b) { float r; asm("v_max_f32_e32 %0, %1, %2" : "=v"(r) : "v"(a), "v"(b)); return r; }
#define ATT_SBAR() __builtin_amdgcn_sched_barrier(0)
#ifndef ATT_VPF
#define ATT_VPF 3
#endif
__device__ __forceinline__ u32x4 att_pack8(const f32x16& x, int b) { return (u32x4){pk2(x[b], x[b + 1]), pk2(x[b + 2], x[b + 3]), pk2(x[b + 4], x[b + 5]), pk2(x[b + 6], x[b + 7])}; }
template <bool TRACK, bool HAS_CUR, bool HAS_NEXT>
__device__ __forceinline__ void att_step(f32x16 (&o)[4], f32x16& e0, f32x16& e1, f32x16& c0, f32x16& c1, float& m, float& l, f32x16& negm,
                                         const bf16x8 (&qr)[4], const LAS unsigned char* kb_next, const LAS unsigned char* vb_prev, LAS float* wsf, int r32, int hi) {
    float mx0 = (TRACK && HAS_CUR) ? c0[0] : 0.f, mx1 = (TRACK && HAS_CUR) ? c1[0] : 0.f, s0 = e0[0], s1 = e1[0];
    {
        constexpr int VPF = TRACK ? 2 : ATT_VPF, NB = VPF + 1;
        s16x4 flo[NB], fhi[NB]; u32x4 pw;
#define ATT_VRD(i, slot) do { flo[slot] = vtr(vb_prev + ((((i) & 3) * 4) + ((i) >> 2)) * 1024); fhi[slot] = vtr(vb_prev + ((((i) & 3) * 4) + ((i) >> 2)) * 1024 + 512); } while (0)
#pragma unroll
        for (int i = 0; i < VPF; ++i) ATT_VRD(i, i);
#pragma unroll
        for (int i = 0; i < 16; ++i) {
            if (i + VPF < 16) ATT_VRD(i + VPF, (i + VPF) % NB);
            if ((i & 3) == 0) { const int ks = i >> 2; pw = (ks < 2) ? att_pack8(e0, 8 * (ks & 1)) : att_pack8(e1, 8 * (ks & 1)); }
            const bf16x8 vf = (bf16x8){flo[i % NB][0], flo[i % NB][1], flo[i % NB][2], flo[i % NB][3], fhi[i % NB][0], fhi[i % NB][1], fhi[i % NB][2], fhi[i % NB][3]};
            o[i & 3] = MF32(__builtin_bit_cast(bf16x8, pw), vf, o[i & 3]);
            if (i > 0) { s0 = fadd_s(s0, e0[i]); s1 = fadd_s(s1, e1[i]); }
            if (TRACK && HAS_CUR && i > 0) { if (i & 1) mx0 = fmax3_s(mx0, c0[i], c1[i]); else mx1 = fmax3_s(mx1, c0[i], c1[i]); }
            ATT_SBAR();
        }
#undef ATT_VRD
    }
    l += s0 + s1;
    if (HAS_CUR) {
        float rm = fmaxf(mx0, mx1); if (TRACK) rm = fmaxf(rm, __shfl_xor(rm, 32));
        if (TRACK && __any(rm > ATT_THR)) {
            const float dl = fmaxf(rm, 0.f), alpha = __builtin_amdgcn_exp2f(-dl); m += dl; l *= alpha;
#pragma unroll
            for (int r = 0; r < 16; ++r) { c0[r] -= dl; c1[r] -= dl; negm[r] = -m; }
            if (hi == 0) wsf[r32] = alpha;
            LDS_WAIT();
#pragma unroll
            for (int r = 0; r < 16; ++r) { const float ar = wsf[crow(r, hi)];
#pragma unroll
                for (int d = 0; d < 4; ++d) o[d][r] *= ar; }
        }
        ATT_SBAR();
        if (HAS_NEXT) {
            bf16x8 ka[2], kc[2];
            ka[0] = *(const LAS bf16x8*)(kb_next); kc[0] = *(const LAS bf16x8*)(kb_next + 512);
#pragma unroll
            for (int d0 = 0; d0 < 4; ++d0) {
                if (d0 < 3) { ka[(d0 + 1) & 1] = *(const LAS bf16x8*)(kb_next + (d0 + 1) * 2048); kc[(d0 + 1) & 1] = *(const LAS bf16x8*)(kb_next + (d0 + 1) * 2048 + 512); }
                if (d0 == 0) e0 = MF32(ka[0], qr[0], negm); else e0 = MF32(ka[d0 & 1], qr[d0], e0);
#pragma unroll
                for (int r = 4 * d0; r < 4 * d0 + 4; ++r) c0[r] = __builtin_amdgcn_exp2f(c0[r]);
                ATT_SBAR();
                if (d0 == 0) e1 = MF32(kc[0], qr[0], negm); else e1 = MF32(kc[d0 & 1], qr[d0], e1);
#pragma unroll
                for (int r = 4 * d0; r < 4 * d0 + 4; ++r) c1[r] = __builtin_amdgcn_exp2f(c1[r]);
                ATT_SBAR();
            }
        } else {
#pragma unroll
            for (int r = 0; r < 16; ++r) { c0[r] = __builtin_amdgcn_exp2f(c0[r]); c1[r] = __builtin_amdgcn_exp2f(c1[r]); }
        }
        asm volatile("" : "+v"(c0), "+v"(c1));
        ATT_SBAR();
    }
}
__device__ __forceinline__ void att_qk_c(f32x16& n0, f32x16& n1, const LAS unsigned char* kb, const bf16x8 (&qr)[4], const f32x16& negm) {
#pragma unroll
    for (int d0 = 0; d0 < 4; ++d0) {
        const bf16x8 a0 = *(const LAS bf16x8*)(kb + d0 * 2048), a1 = *(const LAS bf16x8*)(kb + d0 * 2048 + 512);
        if (d0 == 0) { n0 = MF32(a0, qr[0], negm); n1 = MF32(a1, qr[0], negm); } else { n0 = MF32(a0, qr[d0], n0); n1 = MF32(a1, qr[d0], n1); } }
}
constexpr float ATT_HEADROOM = 64.0f;
#ifndef ATT_FAST_TRACK
#define ATT_FAST_TRACK false
#endif
template <bool TRACK>
__device__ __forceinline__ bool attn_unit(int b, int h, int qb, const bf16_t* Qg, const bf16_t* Kg, const bf16_t* Vg, bf16_t* MIX, const float* g_subln, float lam, LAS unsigned char* lds) {
    const int tid = threadIdx.x, lane = tid & 63, r32 = lane & 31, hi = lane >> 5;
    const int wid = __builtin_amdgcn_readfirstlane(tid >> 6), c = wid >> 2, wq = wid & 3;
    const size_t rowbase = (size_t)b * SEQ; const int q0 = qb * 128 + wq * 32;
    constexpr int NT = SEQ / 64;
    bf16x8 qr[4];
    { const bf16_t* qp = Qg + (rowbase + q0 + r32) * PARTW + h * 128 + c * 64 + hi * 8;
#pragma unroll
      for (int d0 = 0; d0 < 4; ++d0) qr[d0] = *(const bf16x8*)(qp + d0 * 16); }
    const bf16_t* ksrc = Kg + (rowbase + lane) * PARTW + h * 128;
    const bf16_t* vsrc = Vg + (rowbase + (lane >> 2)) * PARTW + h * 128 + (lane & 3) * 8;
    const unsigned lds0 = (unsigned)(uintptr_t)lds;
#define AT_KSLOT(s) ((s) * 16384)
#define AT_VSLOT(s) (49152 + (s) * 16384)
#define AT_DMA_K(t, s) do { _Pragma("unroll") for (int _i = 0; _i < 2; ++_i) { const int kc = wid + 8 * _i; \
        glds16(ksrc + (size_t)(t) * 64 * PARTW + kc * 8, (unsigned)__builtin_amdgcn_readfirstlane((int)(lds0 + AT_KSLOT(s) + kc * 1024))); } } while (0)
#define AT_DMA_V(t, s) do { _Pragma("unroll") for (int _i = 0; _i < 2; ++_i) { const int pi = wid + 8 * _i, d0v = pi >> 2, kg = pi & 3; \
        glds16(vsrc + ((size_t)(t) * 64 + kg * 16) * PARTW + d0v * 32, (unsigned)__builtin_amdgcn_readfirstlane((int)(lds0 + AT_VSLOT(s) + pi * 1024))); } } while (0)
#define AT_WAITBAR() do { asm volatile("s_waitcnt vmcnt(0) lgkmcnt(0)" ::: "memory"); __builtin_amdgcn_s_barrier(); asm volatile("" ::: "memory"); } while (0)
    f32x16 o[4];
#pragma unroll
    for (int i = 0; i < 4; ++i) o[i] = (f32x16){};
    float mrow, lsum = 0.f;
    LAS float* wsf = (LAS float*)(lds + 98304) + wid * 64;
    const int koff = (c * 8 + hi) * 1024 + r32 * 16;
    const int voff = ((lane >> 4) & 1) * 32 + (lane & 3) * 8 + (4 * hi + ((lane & 15) >> 2)) * 64;
    f32x16 pA0, pA1, pB0, pB1;
    LAS unsigned* redo = (LAS unsigned*)(lds + LDSCTL_OFF + 320);
    if (!TRACK) { if (tid == 0) *redo = 0u; }
    AT_DMA_K(0, 0); AT_DMA_V(0, 0); AT_DMA_K(1, 1);
    AT_WAITBAR();
    AT_DMA_K(2, 2); AT_DMA_V(1, 1);
    f32x16 negm = (f32x16){};
    att_qk_c(pA0, pA1, lds + AT_KSLOT(0) + koff, qr, negm);
    mrow = rowmax32(pA0, pA1); if (!TRACK) mrow += ATT_HEADROOM;
#pragma unroll
    for (int r = 0; r < 16; ++r) negm[r] = -mrow;
    att_qk_c(pB0, pB1, lds + AT_KSLOT(1) + koff, qr, negm);
#pragma unroll
    for (int r = 0; r < 16; ++r) { pA0[r] = __builtin_amdgcn_exp2f(pA0[r] - mrow); pA1[r] = __builtin_amdgcn_exp2f(pA1[r] - mrow); }
    int sk = 2, sv = 0;
#define AT_TOP(t) do { AT_WAITBAR(); const int sk2 = (sk == 2) ? 0 : sk + 1;   \
        if ((t) + 2 < NT) AT_DMA_K((t) + 2, sk2); if ((t) + 1 < NT) AT_DMA_V((t) + 1, sk); } while (0)
#define AT_ADV() do { sk = (sk == 2) ? 0 : sk + 1; sv = (sv == 2) ? 0 : sv + 1; } while (0)
    for (int t = 1; t + 1 < NT; t += 2) {
        AT_TOP(t);
        att_step<TRACK, true, true>(o, pA0, pA1, pB0, pB1, mrow, lsum, negm, qr, lds + AT_KSLOT(sk) + koff, lds + AT_VSLOT(sv) + voff, wsf, r32, hi);
        AT_ADV();
        AT_TOP(t + 1);
        att_step<TRACK, true, true>(o, pB0, pB1, pA0, pA1, mrow, lsum, negm, qr, lds + AT_KSLOT(sk) + koff, lds + AT_VSLOT(sv) + voff, wsf, r32, hi);
        AT_ADV();
    }
    AT_TOP(NT - 1);
    att_step<TRACK, true, false>(o, pA0, pA1, pB0, pB1, mrow, lsum, negm, qr, lds + AT_KSLOT(sk) + koff, lds + AT_VSLOT(sv) + voff, wsf, r32, hi);
    AT_ADV();
    att_step<TRACK, false, false>(o, pB0, pB1, pA0, pA1, mrow, lsum, negm, qr, lds + AT_KSLOT(sk) + koff, lds + AT_VSLOT(sv) + voff, wsf, r32, hi);
    if (!TRACK) { if (__any(!(lsum < 0x1p100f))) { if ((lane & 63) == 0) *redo = 1u; } }
    LDS_WAIT(); __builtin_amdgcn_s_barrier(); asm volatile("" ::: "memory");
    if (!TRACK) { if (__builtin_amdgcn_readfirstlane((int)*redo) != 0) { __builtin_amdgcn_s_barrier(); return false; } }
    float lt = lsum + __shfl_xor(lsum, 32);
    float inv = 1.0f / lt; if (c == 1) inv *= lam;
    if (hi == 0) wsf[r32] = inv;
    LDS_WAIT();
#pragma unroll
    for (int r = 0; r < 16; ++r) { const float ar = wsf[crow(r, hi)];
#pragma unroll
        for (int d = 0; d < 4; ++d) o[d][r] *= ar; }
    LAS float* X = (LAS float*)lds + wq * 4096;
    if (c == 1) {
#pragma unroll
        for (int d = 0; d < 4; ++d)
#pragma unroll
            for (int r = 0; r < 16; ++r) X[(d * 16 + r) * 64 + lane] = o[d][r];
    }
    LDS_WAIT(); __builtin_amdgcn_s_barrier(); asm volatile("" ::: "memory");
    if (c == 0) {
        float gs[4];
#pragma unroll
        for (int d = 0; d < 4; ++d) gs[d] = g_subln[32 * d + r32] * (1.0f - LAMBDA_INIT);
        LAS bf16_t* stg = (LAS bf16_t*)(lds + 65536 + wq * 8192);
#pragma unroll
        for (int r = 0; r < 16; ++r) {
            float ss = 0.f;
#pragma unroll
            for (int d = 0; d < 4; ++d) { o[d][r] -= X[(d * 16 + r) * 64 + lane]; ss += o[d][r] * o[d][r]; }
            ss += __shfl_xor(ss, 1); ss += __shfl_xor(ss, 2); ss += __shfl_xor(ss, 4); ss += __shfl_xor(ss, 8); ss += __shfl_xor(ss, 16);
            const float rn = __builtin_amdgcn_rsqf(ss * (1.0f / 128.0f) + EPS);
#pragma unroll
            for (int d = 0; d < 4; ++d) stg[crow(r, hi) * 128 + 32 * d + r32] = (bf16_t)f2bf(o[d][r] * rn * gs[d]);
        }
        LDS_WAIT();
        bf16_t* ob = MIX + (rowbase + qb * 128 + wq * 32) * DM + h * 128;
#pragma unroll
        for (int i = 0; i < 8; ++i) { const int row = i * 4 + (lane >> 4), ch = lane & 15; *(u32x4*)(ob + (size_t)row * DM + ch * 8) = *(const LAS u32x4*)(stg + row * 128 + ch * 8); }
    }
    LDS_WAIT(); __builtin_amdgcn_s_barrier(); asm volatile("" ::: "memory");
#undef AT_DMA_K
#undef AT_DMA_V
#undef AT_TOP
#undef AT_ADV
#undef AT_WAITBAR
    return true;
}

__device__ __forceinline__ void gmlp_unit(int ck, int hh, const bf16_t* Ug, const bf16_t* Gg, const float* lnstat, const float* ln_g, const float* ln_b, const float* w_sp, const float* b_sp, bf16_t* MIX, LAS unsigned char* lds) {
    const int tid = threadIdx.x, lane = tid & 63; const int wid = __builtin_amdgcn_readfirstlane(tid >> 6);
    constexpr int LDW = 136;
    LAS bf16_t* Ws = (LAS bf16_t*)lds;
    LAS bf16_t* VT = (LAS bf16_t*)(lds + 128 * LDW * 2);
    const size_t row0 = (size_t)ck * 128;
    { const float* wp = w_sp + (size_t)hh * 128 * 128;
#pragma unroll
      for (int i = 0; i < 8; ++i) { const int e = (tid + 512 * i) * 4, pr = e >> 7, qc = e & 127; const f32x4 v = *(const f32x4*)(wp + e);
          u32x2 w; w.x = pk2(v[0], v[1]); w.y = pk2(v[2], v[3]); *(LAS u32x2*)(Ws + pr * LDW + qc) = w; } }
    { const int q = tid & 127, dg = tid >> 7;
      const float* st = lnstat + (row0 + q) * 32; float s = 0.f, sq = 0.f;
#pragma unroll
      for (int i = 0; i < 8; ++i) { const f32x4 t4 = *(const f32x4*)(st + 4 * i); s += t4[0] + t4[2]; sq += t4[1] + t4[3]; }
      const float mean = s * (1.0f / 1024.0f), var = fmaxf(sq * (1.0f / 1024.0f) - mean * mean, 0.f), rstd = 1.0f / sqrtf(var + EPS);
      const bf16_t* gp = Gg + (row0 + q) * PARTW + hh * 128 + dg * 32;
      const float* lg = ln_g + hh * 128 + dg * 32; const float* lb = ln_b + hh * 128 + dg * 32;
#pragma unroll
      for (int i = 0; i < 4; ++i) { const bf16x8 gv = *(const bf16x8*)(gp + 8 * i);
          const f32x4 g0 = *(const f32x4*)(lg + 8 * i), g1 = *(const f32x4*)(lg + 8 * i + 4), b0 = *(const f32x4*)(lb + 8 * i), b1 = *(const f32x4*)(lb + 8 * i + 4);
#pragma unroll
          for (int j = 0; j < 8; ++j) { const int d = dg * 32 + 8 * i + j; const float gg = j < 4 ? g0[j & 3] : g1[j & 3], bbv = j < 4 ? b0[j & 3] : b1[j & 3];
              const float vn = (bf2f((unsigned short)gv[j]) - mean) * rstd * gg + bbv;
              VT[d * LDW + q] = (bf16_t)f2bf(vn); } } }
    LDS_WAIT(); __builtin_amdgcn_s_barrier(); asm volatile("" ::: "memory");
    f32x4 acc[8];
#pragma unroll
    for (int n = 0; n < 8; ++n) acc[n] = (f32x4){0.f, 0.f, 0.f, 0.f};
    const int fr = lane & 15, fq = lane >> 4;
#pragma unroll
    for (int ks = 0; ks < 4; ++ks) {
        const bf16x8 a = *(const LAS bf16x8*)(Ws + (16 * wid + fr) * LDW + 32 * ks + 8 * fq);
#pragma unroll
        for (int n = 0; n < 8; ++n) { const bf16x8 bb = *(const LAS bf16x8*)(VT + (16 * n + fr) * LDW + 32 * ks + 8 * fq);
            acc[n] = __builtin_amdgcn_mfma_f32_16x16x32_bf16(bb, a, acc[n], 0, 0, 0); }
    }
    { const int pr = 16 * wid + fr; const float bs = b_sp[hh * 128 + pr];
      const bf16_t* up = Ug + (row0 + pr) * PARTW + hh * 128 + 4 * fq; bf16_t* op = MIX + (row0 + pr) * DM + 1024 + hh * 128 + 4 * fq;
      u32x2 uv[8];
#pragma unroll
      for (int n = 0; n < 8; ++n) uv[n] = *(const u32x2*)(up + 16 * n);
#pragma unroll
      for (int n = 0; n < 8; ++n) { u32x2 w;
          w.x = pk2(__builtin_bit_cast(float, uv[n].x << 16) * (acc[n][0] + bs), __builtin_bit_cast(float, uv[n].x & 0xffff0000u) * (acc[n][1] + bs));
          w.y = pk2(__builtin_bit_cast(float, uv[n].y << 16) * (acc[n][2] + bs), __builtin_bit_cast(float, uv[n].y & 0xffff0000u) * (acc[n][3] + bs));
          *(u32x2*)(op + 16 * n) = w; } }
    LDS_WAIT(); __builtin_amdgcn_s_barrier(); asm volatile("" ::: "memory");
}

struct Args { const void* in[24]; float* out; unsigned char* ws; int ph_lo, ph_hi; };
constexpr int N_PHASES = 8;
__global__ void __launch_bounds__(512, 2) mk_fwd(Args args) {
    extern __shared__ __attribute__((aligned(16))) unsigned char lds_raw[];
    Frame F;
    F.lds = (LAS unsigned char*)lds_raw;
    F.tid = threadIdx.x; F.lane = F.tid & 63; F.wave = __builtin_amdgcn_readfirstlane(F.tid >> 6);
    F.G = gridDim.x; { const int bx = blockIdx.x; F.vcu = (F.G % 8 == 0) ? (bx % 8) * (F.G / 8) + bx / 8 : bx; }
    F.x = (const float*)args.in[0]; F.p = (const float*)args.in[1]; F.pos = (const int*)args.in[2]; F.g_mix = (const float*)args.in[3]; F.w_in = (const float*)args.in[4];
    F.lq1 = (const float*)args.in[5]; F.lk1 = (const float*)args.in[6]; F.lq2 = (const float*)args.in[7]; F.lk2 = (const float*)args.in[8]; F.g_subln = (const float*)args.in[9];
    F.ln_g = (const float*)args.in[10]; F.ln_b = (const float*)args.in[11]; F.w_sp = (const float*)args.in[12]; F.b_sp = (const float*)args.in[13]; F.w_out = (const float*)args.in[14];
    F.g_ffn = (const float*)args.in[15]; F.w_up = (const float*)args.in[16]; F.conv_w = (const float*)args.in[17]; F.conv_b = (const float*)args.in[18]; F.w_down = (const float*)args.in[19];
    F.g_ple = (const float*)args.in[20]; F.w_gate = (const float*)args.in[21]; F.w_pup = (const float*)args.in[22]; F.g_final = (const float*)args.in[23];
    F.out = args.out; F.ws = args.ws;
    unsigned char* ws = args.ws;
    for (int u = F.tid; u < 512 / 4; u += 512) ((LAS unsigned*)(F.lds + LDSCTL_OFF))[u] = 0u;
    __syncthreads();
    const int lo = args.ph_lo, hi = args.ph_hi;
    XcdBarrier bar; bar.bar = (unsigned*)(ws + WS_CTL) + CW_BAR; bar.x = 0; bar.st = nullptr;
    if (hi - lo > 1) bar = xcd_barrier_post((unsigned*)(ws + WS_CTL) + CW_BAR, (volatile LAS unsigned*)(F.lds + LDSCTL_OFF) + 8);
#ifndef PH_MASK
#define PH_MASK 0x1ff
#endif
#define IN(k) (((PH_MASK >> (k)) & 1) && lo <= (k) && (k) < hi)
#define SEAM(k) do { if (IN(k) && IN((k) + 1)) xcd_barrier(bar); } while (0)

    bf16_t* A = (bf16_t*)(ws + WS_A); bf16_t* HB1 = (bf16_t*)(ws + WS_A); bf16_t* HB2 = (bf16_t*)(ws + WS_H); float* SSQ = (float*)(ws + WS_SSQ);
    bf16_t* QKVUG = (bf16_t*)(ws + WS_QKVUG); bf16_t* MIX = (bf16_t*)(ws + WS_MIX); unsigned char* ACT8 = ws + WS_ACT; bf16_t* ACT = (bf16_t*)(ws + WS_ACT + (size_t)MTOK * K8);
    float* HALO = (float*)(ws + WS_HALO);

    if (IN(0)) { p0_prologue(F); }
    SEAM(0);
    if (IN(1)) {
        { pg8::Gemm g{A, (const bf16_t*)(ws + WS_WINT), MTOK, NIN, DM}; pg8::StaticOrder S; S.init(MTOK, NIN, F.G, (int)blockIdx.x);
          pg8::EpiIn E{QKVUG, (const float*)(ws + WS_ROPE), (float*)(ws + WS_LNST)};
          pg8::gemm_phase<pg8::EpiIn, pg8::StaticOrder, true, true, true>(F.lds, g, S, E, F.wave); }
        if (F.G == 256) {
            if (blockIdx.x < 128) { if (F.tid == 0) (void)q_add((unsigned*)(ws + WS_CTL) + CW_DONE1, 1u); } else conv_drain(F, 0, 128u);
        }
    }
    SEAM(1);
    if (IN(2)) {
        const float s1 = wave_sum(F.lq1[F.lane] * F.lk1[F.lane]), s2 = wave_sum(F.lq2[F.lane] * F.lk2[F.lane]);
        const float lam = expf(s1) - expf(s2) + LAMBDA_INIT;
        for (int u = F.vcu; u < NBATCH * NHEAD * 16; u += F.G) { const int bh = u >> 4, qb = u & 15;
            if (!attn_unit<ATT_FAST_TRACK>(bh >> 3, bh & 7, qb, QKVUG, QKVUG + PART_ELEMS, QKVUG + 2 * PART_ELEMS, MIX, F.g_subln, lam, F.lds))
                (void)attn_unit<true>(bh >> 3, bh & 7, qb, QKVUG, QKVUG + PART_ELEMS, QKVUG + 2 * PART_ELEMS, MIX, F.g_subln, lam, F.lds); }
        for (int u = F.vcu; u < 64 * 8; u += F.G) { const int ck = u >> 3, hh = u & 7;
            gmlp_unit(ck, hh, QKVUG + 3 * PART_ELEMS, QKVUG + 4 * PART_ELEMS, (const float*)(ws + WS_LNST), F.ln_g, F.ln_b, F.w_sp, F.b_sp, MIX, F.lds); }
        conv_drain(F, 0, 0u);
    }
    SEAM(2);
    if (IN(3)) {
        pg8::Gemm g{MIX, (const bf16_t*)(ws + WS_WOUTT), MTOK, DM, DM}; pg8::StaticOrder S; S.init(MTOK, DM, F.G, (int)blockIdx.x);
        pg8::EpiResid<2> E{HB1, HB1, SSQ, SSQ + 3 * MTOK, F.g_mix};
        pg8::gemm_phase<pg8::EpiResid<2>, pg8::StaticOrder, true, true>(F.lds, g, S, E, F.wave);
    }
    SEAM(3);
    if (IN(4)) {
        pg8::Gemm g{HB1, (const bf16_t*)(ws + WS_WUPT), MTOK, NUP, DM}; pg8::StaticOrder S; S.init(MTOK, NUP, F.G, (int)blockIdx.x);
        pg8::EpiConvGlu E{ACT, HALO, SSQ, F.conv_w, F.conv_b, F.lds + XLDS_OFF, ACT8};
        pg8::gemm_phase<pg8::EpiConvGlu, pg8::StaticOrder, true, true, true>(F.lds, g, S, E, F.wave);
        {
            const bool split = (F.G == 256), is_long = split && blockIdx.x < 128;
            pg8::SmallOrder S2;
            if (split) { S2.first = 2 * ((int)blockIdx.x - 128); S2.stride = 1; S2.count = is_long ? 0 : 2; }
            else { S2.first = (int)blockIdx.x; S2.stride = F.G; S2.count = ((int)blockIdx.x < 256) ? (256 - (int)blockIdx.x + F.G - 1) / F.G : 0; }
            int zero = 0; asm volatile("" : "+s"(zero));
            S2.first += zero;
            pg8::Gemm g2{(const bf16_t*)(ws + WS_PB), (const bf16_t*)(ws + WS_WPUT), MTOK, DM, PLE};
            pg8::EpiBf16 E2{(bf16_t*)(ws + WS_UPB), DM};
            pg8::gemm_phase<pg8::EpiBf16, pg8::SmallOrder, false, true, true>(F.lds, g2, S2, E2, F.wave, zero);
            if (split) { if (is_long) { if (F.tid == 0) (void)q_add((unsigned*)(ws + WS_CTL) + CW_DONE4, 1u); } else conv_drain(F, 1, 128u); }
        }
    }
    SEAM(4);
    if (IN(5)) {
        const int gt = F.vcu * 512 + F.tid, NGT = F.G * 512;
        constexpr int NB = MTOK / 256 - 1;
        for (int i = gt; i < NB * 2 * DFF; i += NGT) {
            const int ch = i % DFF, w = (i / DFF) & 1, bnd = i / (2 * DFF) + 1;
            if ((bnd & 7) == 0) continue;
            const int pn = ch >> 7, cc = ch & 127; const size_t gi = (size_t)pn * 256 + cc, ui = gi + 128;
            const float* hA = HALO + (size_t)(bnd - 1) * 4 * NUP; const float* hB = HALO + (size_t)bnd * 4 * NUP;
            const float* rp = (w == 0) ? hA + 2 * NUP : hA + 3 * NUP;
            const float* rc = (w == 0) ? hA + 3 * NUP : hB;
            const float* rn = (w == 0) ? hB : hB + NUP;
            const float gq = F.conv_w[ch] * rp[gi] + F.conv_w[NUP + ch] * rc[gi] + F.conv_w[2 * NUP + ch] * rn[gi] + F.conv_b[ch];
            const float uq = F.conv_w[DFF + ch] * rp[ui] + F.conv_w[NUP + DFF + ch] * rc[ui] + F.conv_w[2 * NUP + DFF + ch] * rn[ui] + F.conv_b[DFF + ch];
            const size_t row = (size_t)bnd * 256 - 1 + w;
            const float av = gq * __builtin_amdgcn_rcpf(1.0f + __builtin_amdgcn_exp2f(gq * (-LOG2E))) * uq;
            if (ch < K8) ACT8[row * K8 + ch] = (unsigned char)(__builtin_amdgcn_cvt_pk_fp8_f32(av, 0.f, 0, false) & 0xff);
            else ACT[row * (DFF - K8) + (ch - K8)] = (bf16_t)f2bf(av);
        }
        conv_drain(F, 1, 0u);
    }
    SEAM(5);
    if (IN(6)) {
        pg8::StaticOrder S; S.init(MTOK, DM, F.G, (int)blockIdx.x);
        for (int ui = 0; ; ++ui) {
            pg8::OneUnit S1; if (!S.next(ui, S1.u)) break;
            f32x4 acc5[2][2][4][2];
            { pg8::Gemm g8{(const bf16_t*)ACT8, (const bf16_t*)(ws + WS_WDT), MTOK, DM, K8};
              pg8::EpiScale E8{1.0f / W8_SCALE};
              pg8::gemm_phase_x<pg8::EpiScale, pg8::OneUnit, true, true, false, true, true>(F.lds, g8, S1, E8, acc5, F.wave, 0); }
            { pg8::Gemm g{ACT, (const bf16_t*)(ws + WS_WDT + (size_t)DM * K8), MTOK, DM, DFF - K8};
              pg8::EpiResid<1, true> E{HB1, HB2, SSQ + MTOK, nullptr, nullptr, ws + WS_A8};
              pg8::gemm_phase_x<pg8::EpiResid<1, true>, pg8::OneUnit, true, true, false, false, false>(F.lds, g, S1, E, acc5, F.wave, 0); }
        }
    }
    SEAM(6);
    if (IN(7)) {
        bf16_t* UPB = (bf16_t*)(ws + WS_UPB);
        int zero = 0; asm volatile("" : "+s"(zero));
        pg8::Gemm g{(const bf16_t*)(ws + WS_A8), (const bf16_t*)(ws + WS_WGT), MTOK, DM, DM}; pg8::StaticOrder S; S.init(MTOK, DM, F.G, (int)blockIdx.x + zero);
        pg8::EpiPle<true> E{HB2, UPB, F.out, SSQ + MTOK, SSQ + 2 * MTOK, (unsigned*)(ws + WS_CTL) + CW_PANEL, F.g_final, 1.0f / W8_SCALE};
        pg8::gemm_phase<pg8::EpiPle<true>, pg8::StaticOrder, true, true, false, true>(F.lds, g, S, E, F.wave, zero);
    }
#undef IN
#undef SEAM
}

extern "C" void kernel_launch(void* const* d_in, const int* in_sizes, int n_in, void* d_out, int out_size, void* d_ws, size_t ws_size, hipStream_t stream) {
    static int grid = 0;
    if (grid == 0) {
        if (n_in != 24 || in_sizes[0] != MTOK * DM || out_size != MTOK * DM || ws_size < WS_END) {
            fprintf(stderr, "kernel_launch: unexpected shapes: n_in %d in0 %d out %d ws %zu (need %zu)\n", n_in, n_in > 0 ? in_sizes[0] : -1, out_size, ws_size, (size_t)WS_END); grid = -1; return; }
        int dev = 0, cus = 0, per_cu = 0;
        if (hipGetDevice(&dev) != hipSuccess || hipDeviceGetAttribute(&cus, hipDeviceAttributeMultiprocessorCount, dev) != hipSuccess) { grid = -1; return; }
        if (hipFuncSetAttribute((const void*)mk_fwd, hipFuncAttributeMaxDynamicSharedMemorySize, LDS_BYTES) != hipSuccess) { fprintf(stderr, "kernel_launch: hipFuncSetAttribute failed\n"); grid = -1; return; }
        if (hipOccupancyMaxActiveBlocksPerMultiprocessor(&per_cu, (const void*)mk_fwd, 512, LDS_BYTES) != hipSuccess || per_cu < 1) { fprintf(stderr, "kernel_launch: occupancy query says %d blocks/CU\n", per_cu); per_cu = 1; }
        (void)hipGetLastError();
        if (cus != 256) fprintf(stderr, "kernel_launch: built for a 256-CU device (one 256 x 256 unit per workgroup in the fused final-norm phase); this device has %d CUs: the output will be wrong\n", cus);
        grid = cus;
    }
    if (grid < 0) return;
    (void)hipMemsetAsync((char*)d_ws + WS_CTL, 0, CTL_ZERO_BYTES, stream);
    Args a{};
    for (int i = 0; i < 24; ++i) a.in[i] = d_in[i];
    a.out = (float*)d_out; a.ws = (unsigned char*)d_ws;
#if MK_N_LAUNCHES == 1
    a.ph_lo = 0; a.ph_hi = N_PHASES;
    hipLaunchKernelGGL(mk_fwd, dim3(grid), dim3(512), LDS_BYTES, stream, a);
#else
    for (int li = 0; li < N_PHASES; ++li) { a.ph_lo = li; a.ph_hi = li + 1; hipLaunchKernelGGL(mk_fwd, dim3(grid), dim3(512), LDS_BYTES, stream, a); }
#endif
}
```
